# Optimizing an MI355X kernel written in HIP

```python
import math
import jax
import jax.numpy as jnp
from jax import lax
import numpy as np

D_MODEL = 1024
BATCH = 32
SEQ = 2048
DEPTH = 4

GRID_W = 64
CTX_LEN = 256
N_EVEN = (DEPTH + 1) // 2
N_ODD = DEPTH // 2
EPS = 1e-6
CONV_W = 3

GLA_HEADS = 4
GLA_DK = 64
GLA_DV = 128
GLA_RANK = 16
GLA_TAU = 16.0
GLA_CHUNK = 64
GLA_QK = GLA_HEADS * GLA_DK
GLA_V = GLA_HEADS * GLA_DV

HY_WIDTH = 512
HY_EMB = 33
HY_BANDS = (HY_EMB - 1) // 2
HY_HIDDEN = 64
HY_FAST_DECAY = 0.3
HY_SLOW_DECAY = 1.5
HY_TARGET = 1e-2

EV_SPLIT = (GLA_QK, 2 * GLA_QK, 2 * GLA_QK + GLA_V, 2 * GLA_QK + 2 * GLA_V,
            2 * GLA_QK + 2 * GLA_V + GLA_RANK, 2 * GLA_QK + 2 * GLA_V + 2 * GLA_RANK)
EV_IN = 2 * GLA_QK + 2 * GLA_V + 2 * GLA_RANK + 3 * HY_WIDTH
EV_MIX = GLA_V + HY_WIDTH

SC_WIDTH = D_MODEL

N_GROUPS = 4
EXP_PER_GROUP = 8
N_EXPERTS = N_GROUPS * EXP_PER_GROUP
TOP_K = 2
D_EXPERT = 512
MOE_BLOCK = 128

kernel_name = 'hybrid_gla_hyena_shortconv_hmoe_dit'


def rmsnorm(x, g):
    xf = x.astype(jnp.float32)
    y = xf * lax.rsqrt(jnp.mean(xf * xf, axis=-1, keepdims=True) + EPS)
    return (y * g.astype(jnp.float32)).astype(x.dtype)


def modulate(x, shift, scale):
    return x * (1 + scale) + shift


def dwconv3(x, w, b=None):
    xp = jnp.pad(x, ((0, 0), (1, 1), (0, 0)))
    y = w[0] * xp[:, :-2] + w[1] * xp[:, 1:-1] + w[2] * xp[:, 2:]
    return y if b is None else y + b


def flip(a):
    return jnp.flip(a, axis=1)


def to_col_major(h):
    B, S, D = h.shape
    rows = S // GRID_W
    return h.reshape(B, rows, GRID_W, D).transpose(0, 2, 1, 3).reshape(B, S, D)


def to_row_major(h):
    B, S, D = h.shape
    rows = S // GRID_W
    return h.reshape(B, GRID_W, rows, D).transpose(0, 2, 1, 3).reshape(B, S, D)


def gla_chunked(q, k, v, g, s0):
    B, L, H, dk = q.shape
    dv = v.shape[-1]
    C = GLA_CHUNK
    n = L // C
    f32 = jnp.float32
    q = q.astype(f32).reshape(B, n, C, H, dk)
    k = k.astype(f32).reshape(B, n, C, H, dk)
    v = v.astype(f32).reshape(B, n, C, H, dv)
    b = jnp.cumsum(g.astype(f32).reshape(B, n, C, H, dk), axis=2)
    b_last = b[:, :, -1]
    qd = q * jnp.exp(b)
    kd = k * jnp.exp(-b)
    kr = k * jnp.exp(b_last[:, :, None] - b)
    mask = jnp.tril(jnp.ones((C, C), dtype=bool))
    a = jnp.where(mask, jnp.einsum('bnthd,bnshd->bnhts', qd, kd), 0.0)
    o_intra = jnp.einsum('bnhts,bnshe->bnthe', a, v)
    ds = jnp.einsum('bnshd,bnshe->bnhde', kr, v)
    decay = jnp.exp(b_last)

    def step(s, inp):
        d, dsn = inp
        return d[..., None] * s + dsn, s

    s_final, s_before = lax.scan(step, s0, (jnp.moveaxis(decay, 1, 0), jnp.moveaxis(ds, 1, 0)))
    s_before = jnp.moveaxis(s_before, 0, 1)
    o_inter = jnp.einsum('bnthd,bnhde->bnthe', qd, s_before)
    return (o_intra + o_inter).reshape(B, L, H, dv), s_final


def gla_split(p, wa_f, ba_f, wa_b, ba_b):
    B, L, _ = p.shape
    q, k, v, g, rf, rb, hy = jnp.split(p, EV_SPLIT, axis=-1)
    q = q.reshape(B, L, GLA_HEADS, GLA_DK) * GLA_DK ** -0.5
    k = k.reshape(B, L, GLA_HEADS, GLA_DK)
    v = v.reshape(B, L, GLA_HEADS, GLA_DV)
    gf = (jax.nn.log_sigmoid((rf @ wa_f + ba_f).astype(jnp.float32)) / GLA_TAU).reshape(B, L, GLA_HEADS, GLA_DK)
    gb = (jax.nn.log_sigmoid((rb @ wa_b + ba_b).astype(jnp.float32)) / GLA_TAU).reshape(B, L, GLA_HEADS, GLA_DK)
    return q, k, v, g, gf, gb, hy


def gla_readout(o, g, gain):
    B, L = o.shape[:2]
    o = o * lax.rsqrt(jnp.mean(o * o, axis=-1, keepdims=True) + EPS) * gain.astype(jnp.float32)
    return o.reshape(B, L, GLA_V).astype(g.dtype) * jax.nn.silu(g)


def hyena_filters(L, w1, b1, f1, w2, b2, f2, w3):
    f32 = jnp.float32
    t = jnp.linspace(0.0, 1.0, L, dtype=f32)[:, None]
    pos = jnp.arange(L, dtype=f32)[:, None]
    bands = jnp.linspace(1e-4, HY_BANDS - 1, HY_BANDS, dtype=f32)[None]
    ang = (2.0 * math.pi / L) * pos * bands
    z = jnp.concatenate([t, jnp.cos(ang), jnp.sin(ang)], axis=-1)
    hh = jnp.sin(f1 * (z @ w1 + b1))
    hh = jnp.sin(f2 * (hh @ w2 + b2))
    hh = (hh @ w3).astype(f32)
    max_decay = math.log(HY_TARGET) / HY_FAST_DECAY
    min_decay = math.log(HY_TARGET) / HY_SLOW_DECAY
    deltas = jnp.linspace(min_decay, max_decay, HY_WIDTH, dtype=f32)
    window = jnp.exp(-t * jnp.abs(deltas)[None])
    hh = hh.reshape(L, 2, HY_WIDTH) * window[:, None]
    return hh[:, 0], hh[:, 1]


def bidir_fftconv(u, h_fwd, h_bwd, skip):
    L = u.shape[1]
    n = 2 * L
    uf = u.astype(jnp.float32)
    U = jnp.fft.rfft(uf, n=n, axis=1)
    K = jnp.fft.rfft(h_fwd, n=n, axis=0) + jnp.conj(jnp.fft.rfft(h_bwd, n=n, axis=0))
    y = jnp.fft.irfft(U * K[None], n=n, axis=1)[:, :L]
    return (y + uf * skip.astype(jnp.float32)).astype(u.dtype)


def hyena_mix(p, filt, conv_w, conv_b, skip):
    pc = dwconv3(p, conv_w, conv_b)
    x0, x1, v = jnp.split(pc, 3, axis=-1)
    return x0 * bidir_fftconv(v * x1, filt[0], filt[1], skip)


def even_mixer(u, uc, w_in, w_out, wa_f, ba_f, wa_b, ba_b, gla_gain,
               conv_w, conv_b, w1, b1, f1, w2, b2, f2, w3, skip, ctx_out):
    ql, kl, vl, gl, gfl, gbl, hl = gla_split(u @ w_in, wa_f, ba_f, wa_b, ba_b)
    qc, kc, vc, gc, gfc, gbc, hc = gla_split(uc @ w_in, wa_f, ba_f, wa_b, ba_b)
    s0 = jnp.zeros((u.shape[0], GLA_HEADS, GLA_DK, GLA_DV), jnp.float32)
    oc_f, sc_f = gla_chunked(qc, kc, vc, gfc, s0)
    oc_b, sc_b = gla_chunked(flip(qc), flip(kc), flip(vc), flip(gbc), s0)
    ol_f, _ = gla_chunked(ql, kl, vl, gfl, sc_f)
    ol_b, _ = gla_chunked(flip(ql), flip(kl), flip(vl), flip(gbl), sc_b)
    hw = (w1, b1, f1, w2, b2, f2, w3)
    yl = jnp.concatenate([gla_readout(ol_f + flip(ol_b), gl, gla_gain),
                          hyena_mix(hl, hyena_filters(u.shape[1], *hw), conv_w, conv_b, skip)], axis=-1) @ w_out
    yc = None
    if ctx_out:
        yc = jnp.concatenate([gla_readout(oc_f + flip(oc_b), gc, gla_gain),
                              hyena_mix(hc, hyena_filters(uc.shape[1], *hw), conv_w, conv_b, skip)], axis=-1) @ w_out
    return yl, yc


def shortconv_mixer(u, w_in, conv_w, w_out):
    bg, cg, xin = jnp.split(u @ w_in, 3, axis=-1)
    return (bg * dwconv3(cg * xin, conv_w)) @ w_out


def grouped_experts(xt, expert, gate, w1, w3, w2):
    T, D = xt.shape
    M = T * TOP_K
    flat_e = expert.reshape(M)
    flat_t = jnp.repeat(jnp.arange(T, dtype=jnp.int32), TOP_K)
    flat_g = gate.reshape(M)
    order = jnp.argsort(flat_e)
    se = flat_e[order]
    counts = jnp.bincount(flat_e, length=N_EXPERTS)
    padded = (counts + MOE_BLOCK - 1) // MOE_BLOCK * MOE_BLOCK
    start = jnp.cumsum(counts) - counts
    pend = jnp.cumsum(padded)
    pstart = pend - padded
    dest = pstart[se] + jnp.arange(M, dtype=jnp.int32) - start[se]
    n_blocks = -(-(M + N_EXPERTS * (MOE_BLOCK - 1)) // MOE_BLOCK)
    P = n_blocks * MOE_BLOCK
    slot_t = jnp.full((P,), T, jnp.int32).at[dest].set(flat_t[order])
    slot_g = jnp.zeros((P,), gate.dtype).at[dest].set(flat_g[order])
    blk_e = jnp.minimum(jnp.searchsorted(pend, jnp.arange(n_blocks, dtype=jnp.int32) * MOE_BLOCK, side='right'),
                        N_EXPERTS - 1)
    x_pad = jnp.concatenate([xt, jnp.zeros((1, D), xt.dtype)], axis=0)

    def run_block(args):
        tok, e = args
        xb = x_pad[tok]
        return (jax.nn.silu(xb @ w1[e]) * (xb @ w3[e])) @ w2[e]

    yb = lax.map(run_block, (slot_t.reshape(n_blocks, MOE_BLOCK), blk_e))
    y = yb.reshape(P, D) * slot_g[:, None]
    return jax.ops.segment_sum(y, slot_t, num_segments=T + 1)[:T]


def hier_moe(xt, w_grp, b_grp, w_exp, b_exp, w1, w3, w2):
    T = xt.shape[0]
    lg = (xt @ w_grp + b_grp).astype(jnp.float32)
    p_grp = jax.nn.softmax(lg, axis=-1)
    p_g, grp = lax.top_k(p_grp, 1)
    le = (xt @ w_exp + b_exp).astype(jnp.float32).reshape(T, N_GROUPS, EXP_PER_GROUP)
    le = jnp.take_along_axis(le, grp[:, :, None], axis=1)[:, 0]
    top_p, top_i = lax.top_k(jax.nn.softmax(le, axis=-1), TOP_K)
    gate = p_g * top_p / jnp.sum(top_p, axis=-1, keepdims=True)
    expert = grp * EXP_PER_GROUP + top_i
    return grouped_experts(xt, expert, gate.astype(xt.dtype), w1, w3, w2)


def setup_inputs(seed: int = 0) -> dict:
    key = jax.random.key(seed)
    ks = iter(jax.random.split(key, 48))
    D = D_MODEL

    def nrm(shape, scale):
        return scale * jax.random.normal(next(ks), shape, jnp.float32)

    return {
        'x': nrm((BATCH, SEQ, D), 1.0),
        'c': nrm((BATCH, D), 1.0),
        'ctx': nrm((BATCH, CTX_LEN, D), 1.0),
        'c_ctx': nrm((D,), 1.0),
        'mod_w': nrm((DEPTH, D, 6 * D), 0.5 * D ** -0.5),
        'mod_b': nrm((DEPTH, 6 * D), 0.02),
        'norm_mix': 1.0 + nrm((DEPTH, D), 0.02),
        'norm_ffn': 1.0 + nrm((DEPTH, D), 0.02),
        'norm_final': 1.0 + nrm((D,), 0.02),
        'ev_w_in': nrm((N_EVEN, D, EV_IN), D ** -0.5),
        'ev_w_out': nrm((N_EVEN, EV_MIX, D), EV_MIX ** -0.5),
        'gla_wa_f': nrm((N_EVEN, GLA_RANK, GLA_QK), GLA_RANK ** -0.5),
        'gla_ba_f': nrm((N_EVEN, GLA_QK), 0.1),
        'gla_wa_b': nrm((N_EVEN, GLA_RANK, GLA_QK), GLA_RANK ** -0.5),
        'gla_ba_b': nrm((N_EVEN, GLA_QK), 0.1),
        'gla_norm': 1.0 + nrm((N_EVEN, GLA_DV), 0.02),
        'hy_conv_w': nrm((N_EVEN, CONV_W, 3 * HY_WIDTH), CONV_W ** -0.5),
        'hy_conv_b': nrm((N_EVEN, 3 * HY_WIDTH), 0.02),
        'hy_w1': nrm((N_EVEN, HY_EMB, HY_HIDDEN), HY_EMB ** -0.5),
        'hy_b1': nrm((N_EVEN, HY_HIDDEN), 0.1),
        'hy_f1': 1.0 + nrm((N_EVEN, HY_HIDDEN), 0.02),
        'hy_w2': nrm((N_EVEN, HY_HIDDEN, HY_HIDDEN), HY_HIDDEN ** -0.5),
        'hy_b2': nrm((N_EVEN, HY_HIDDEN), 0.1),
        'hy_f2': 1.0 + nrm((N_EVEN, HY_HIDDEN), 0.02),
        'hy_w3': nrm((N_EVEN, HY_HIDDEN, 2 * HY_WIDTH), 0.02),
        'hy_skip': nrm((N_EVEN, HY_WIDTH), 0.5),
        'od_w_in': nrm((N_ODD, D, 3 * SC_WIDTH), D ** -0.5),
        'od_conv_w': nrm((N_ODD, CONV_W, SC_WIDTH), CONV_W ** -0.5),
        'od_w_out': nrm((N_ODD, SC_WIDTH, D), SC_WIDTH ** -0.5),
        'rt_w_grp': nrm((DEPTH, D, N_GROUPS), D ** -0.5),
        'rt_b_grp': nrm((DEPTH, N_GROUPS), 0.01),
        'rt_w_exp': nrm((DEPTH, D, N_EXPERTS), D ** -0.5),
        'rt_b_exp': nrm((DEPTH, N_EXPERTS), 0.01),
        'ex_w1': nrm((DEPTH, N_EXPERTS, D, D_EXPERT), D ** -0.5),
        'ex_w3': nrm((DEPTH, N_EXPERTS, D, D_EXPERT), D ** -0.5),
        'ex_w2': nrm((DEPTH, N_EXPERTS, D_EXPERT, D), D_EXPERT ** -0.5),
    }


def reference(x, c, ctx, c_ctx, mod_w, mod_b, norm_mix, norm_ffn, norm_final,
              ev_w_in, ev_w_out, gla_wa_f, gla_ba_f, gla_wa_b, gla_ba_b, gla_norm,
              hy_conv_w, hy_conv_b, hy_w1, hy_b1, hy_f1, hy_w2, hy_b2, hy_f2, hy_w3, hy_skip,
              od_w_in, od_conv_w, od_w_out,
              rt_w_grp, rt_b_grp, rt_w_exp, rt_b_exp, ex_w1, ex_w3, ex_w2):
    B, S, D = x.shape
    Lc = ctx.shape[1]
    h, hc = x, ctx
    s_lat = jax.nn.silu(c)
    s_ctx = jax.nn.silu(c_ctx)
    for l in range(DEPTH):
        i = l // 2
        even = l % 2 == 0
        ctx_out = l < DEPTH - 1
        col_major = i % 2 == 1
        m_lat = jnp.split((s_lat @ mod_w[l] + mod_b[l])[:, None, :], 6, axis=-1)
        m_ctx = jnp.split(s_ctx @ mod_w[l] + mod_b[l], 6, axis=-1)
        u = modulate(rmsnorm(h, norm_mix[l]), m_lat[0], m_lat[1])
        if col_major:
            u = to_col_major(u)
        uc = modulate(rmsnorm(hc, norm_mix[l]), m_ctx[0], m_ctx[1]) if (even or ctx_out) else None
        if even:
            y, yc = even_mixer(u, uc, ev_w_in[i], ev_w_out[i], gla_wa_f[i], gla_ba_f[i], gla_wa_b[i], gla_ba_b[i],
                               gla_norm[i], hy_conv_w[i], hy_conv_b[i], hy_w1[i], hy_b1[i], hy_f1[i],
                               hy_w2[i], hy_b2[i], hy_f2[i], hy_w3[i], hy_skip[i], ctx_out)
        else:
            y = shortconv_mixer(u, od_w_in[i], od_conv_w[i], od_w_out[i])
            yc = shortconv_mixer(uc, od_w_in[i], od_conv_w[i], od_w_out[i]) if ctx_out else None
        if col_major:
            y = to_row_major(y)
        h = h + m_lat[2] * y
        v = modulate(rmsnorm(h, norm_ffn[l]), m_lat[3], m_lat[4]).reshape(B * S, D)
        if ctx_out:
            hc = hc + m_ctx[2] * yc
            vc = modulate(rmsnorm(hc, norm_ffn[l]), m_ctx[3], m_ctx[4]).reshape(B * Lc, D)
            f = hier_moe(jnp.concatenate([vc, v], axis=0), rt_w_grp[l], rt_b_grp[l], rt_w_exp[l], rt_b_exp[l],
                         ex_w1[l], ex_w3[l], ex_w2[l])
            hc = hc + m_ctx[5] * f[:B * Lc].reshape(B, Lc, D)
            f = f[B * Lc:]
        else:
            f = hier_moe(v, rt_w_grp[l], rt_b_grp[l], rt_w_exp[l], rt_b_exp[l], ex_w1[l], ex_w3[l], ex_w2[l])
        h = h + m_lat[5] * f.reshape(B, S, D)
    return rmsnorm(h, norm_final)
```

```cpp
#include <hip/hip_runtime.h>
#include <cstdio>
#include <cstdint>

#define LAS __attribute__((address_space(3)))
typedef unsigned short bf16_t;
typedef short bf16x8 __attribute__((ext_vector_type(8)));
typedef float f32x4 __attribute__((ext_vector_type(4)));
typedef float f32x2 __attribute__((ext_vector_type(2)));
typedef unsigned u32x4 __attribute__((ext_vector_type(4)));
typedef unsigned u32x2 __attribute__((ext_vector_type(2)));

constexpr int D = 1024, NB = 32, SEQ = 2048, LC = 256, DEPTH = 4;
constexpr int RC = NB * LC;
constexpr int RL = NB * SEQ;
constexpr int RT = RC + RL;
constexpr int EVSRC = 3104, EVN = 3072, EVNP = 3584, ODN = 3072, ODP = 2048;
constexpr int NEXP = 32, DE = 512;
constexpr int HYW = 512;
constexpr int PROWS = 2 * RT + NEXP * 256;
constexpr float EPS = 1e-6f;

constexpr size_t MiB = 1u << 20;
constexpr size_t WS_CTL = 0, CTL_BYTES = 1 * MiB;
constexpr size_t WS_MOD = 1 * MiB;
constexpr size_t WS_KR = 5 * MiB;
constexpr size_t WS_WEVIN = 14 * MiB;
constexpr size_t WS_WEVOUT = 28 * MiB;
constexpr size_t WS_WODIN = 32 * MiB;
constexpr size_t WS_WODOUT = 44 * MiB;
constexpr size_t WS_RW = 48 * MiB;
constexpr size_t WS_REC = 50 * MiB;
constexpr size_t WS_TOK = 52 * MiB;
constexpr size_t WS_H16 = 62 * MiB;
constexpr size_t WS_ACT = 206 * MiB;
constexpr size_t WS_P = 350 * MiB;
constexpr size_t WS_H = WS_P, WS_Y = WS_P + 152 * MiB;
constexpr size_t WS_EXP = 806 * MiB;
constexpr size_t WS_W2T = WS_EXP + 32 * MiB;
constexpr size_t WS_WT = WS_EXP;
constexpr size_t WS_OF = 902 * MiB, WS_OB = 974 * MiB;
constexpr size_t WS_X0T = 1046 * MiB;
constexpr size_t WS_G = 1126 * MiB;
constexpr size_t WS_END = 1198 * MiB;
static_assert((size_t)PROWS * 512 * 2 <= 152 * MiB && (size_t)PROWS * 1024 * 2 <= 304 * MiB && (size_t)RT * 3072 * 2 <= 456 * MiB, "ws map");

constexpr int CW_BAR = 4096;
constexpr int CW_CNT = 8192;
constexpr int CW_XQ = 10240;
constexpr int CW_DIAG = 12288;

constexpr int LDS_BYTES = 147456;
constexpr int LDS_MISC = 143360;
constexpr int MW_BAR = 0, MW_TSTART = 8, MW_CNT = 48, MW_HIST = 80, MW_TILE = 128;

typedef __bf16 bf16x2_t __attribute__((ext_vector_type(2)));
__device__ __forceinline__ unsigned pk2(float lo, float hi) { const f32x2 v = {lo, hi}; const bf16x2_t b = __builtin_convertvector(v, bf16x2_t); return __builtin_bit_cast(unsigned, b); }
__device__ __forceinline__ unsigned f2bf(float f) { return pk2(f, 0.0f) & 0xffffu; }
__device__ __forceinline__ unsigned pk4_fp8(float a, float b, float c, float d) {
    a = __builtin_amdgcn_fmed3f(a, -448.f, 448.f); b = __builtin_amdgcn_fmed3f(b, -448.f, 448.f); c = __builtin_amdgcn_fmed3f(c, -448.f, 448.f); d = __builtin_amdgcn_fmed3f(d, -448.f, 448.f);
    int w = 0; w = __builtin_amdgcn_cvt_pk_fp8_f32(a, b, w, false); w = __builtin_amdgcn_cvt_pk_fp8_f32(c, d, w, true); return (unsigned)w; }
__device__ __forceinline__ f32x4 up4_fp8(unsigned w) { const f32x2 lo = __builtin_amdgcn_cvt_pk_f32_fp8((int)w, false), hi = __builtin_amdgcn_cvt_pk_f32_fp8((int)w, true); return (f32x4){lo[0], lo[1], hi[0], hi[1]}; }
constexpr float SC_O = 4.0f;
constexpr float SC_Z = 8.0f, SC_WO = 32.0f;
constexpr int E8_Z = 0x7c7c7c7c, E8_WO = 0x7a7a7a7a;
constexpr float SC_V = 8.0f, SC_W13 = 64.0f, SC_H = 8.0f, SC_W2 = 32.0f, SC_Y = 32.0f;
constexpr int E8_V = 0x7c7c7c7c, E8_W13 = 0x79797979, E8_H = 0x7c7c7c7c, E8_W2 = 0x7a7a7a7a;
constexpr int E8_W13G = 0x7c7c7c7c, E8_W2Y = 0x7f7f7f7f;
__device__ __forceinline__ float bflo(unsigned w) { return __builtin_bit_cast(float, w << 16); }
__device__ __forceinline__ float bfhi(unsigned w) { return __builtin_bit_cast(float, w & 0xffff0000u); }
__device__ __forceinline__ float bf1(bf16_t b) { return __builtin_bit_cast(float, ((unsigned)b) << 16); }
__device__ __forceinline__ float wave_sum(float v) {
    v += __builtin_bit_cast(float, __builtin_amdgcn_update_dpp(0, __builtin_bit_cast(int, v), 0x111, 0xf, 0xf, false));
    v += __builtin_bit_cast(float, __builtin_amdgcn_update_dpp(0, __builtin_bit_cast(int, v), 0x112, 0xf, 0xf, false));
    v += __builtin_bit_cast(float, __builtin_amdgcn_update_dpp(0, __builtin_bit_cast(int, v), 0x114, 0xf, 0xf, false));
    v += __builtin_bit_cast(float, __builtin_amdgcn_update_dpp(0, __builtin_bit_cast(int, v), 0x118, 0xf, 0xf, false));
    v += __builtin_bit_cast(float, __builtin_amdgcn_update_dpp(0, __builtin_bit_cast(int, v), 0x142, 0xa, 0xf, false));
    v += __builtin_bit_cast(float, __builtin_amdgcn_update_dpp(0, __builtin_bit_cast(int, v), 0x143, 0xc, 0xf, false));
    return __builtin_bit_cast(float, __builtin_amdgcn_readlane(__builtin_bit_cast(int, v), 63));
}
__device__ __forceinline__ float silu_f(float x) { return x * __builtin_amdgcn_rcpf(1.0f + __expf(-x)); }
#define LDS_WAIT() asm volatile("s_waitcnt lgkmcnt(0)" ::: "memory")
#define VM_WAIT() asm volatile("s_waitcnt vmcnt(0)" ::: "memory")

__device__ __forceinline__ int lat_row(int b, int j, bool cm) { const int s = cm ? ((j & 31) * 64 + (j >> 5)) : j; return RC + b * SEQ + s; }
__device__ __forceinline__ int seq_nbr(int row, int dlt, bool cm) {
    if (row < RC) { const int b = row >> 8, p = (row & 255) + dlt; return (p < 0 || p >= LC) ? -1 : (b * LC + p); }
    const int r = row - RC, b = r >> 11, s = r & 2047;
    const int j = (cm ? ((s & 63) * 32 + (s >> 6)) : s) + dlt;
    return (j < 0 || j >= SEQ) ? -1 : lat_row(b, j, cm);
}

#define XB_TMO      128
#define XB_XCNT(j)  (256  + 64 * (j))
#define XB_XSUB(j)  (1280 + 64 * (j))
#define XB_XGEN(j)  (2304 + 64 * (j))
#define XB_TOP      3328
#define XB_TOPGEN   3392
#define XCD_BAR_WORDS 3456
#define XB_SPIN_CAP (1u << 22)

__device__ __forceinline__ unsigned xb_ld(unsigned* p)              { return __hip_atomic_load(p, __ATOMIC_RELAXED, __HIP_MEMORY_SCOPE_AGENT); }
__device__ __forceinline__ unsigned xb_add(unsigned* p, unsigned v) { return __hip_atomic_fetch_add(p, v, __ATOMIC_RELAXED, __HIP_MEMORY_SCOPE_AGENT); }
__device__ __forceinline__ unsigned xb_xcc_id() { return (unsigned)__builtin_amdgcn_s_getreg((3 << 11) | 20) & 0xFu; }
#define XB_SPIN(cond, bar) do { unsigned _sp = 0; while (cond) { __builtin_amdgcn_s_sleep(1); \
    if ((++_sp & 255u) == 0u) { if (xb_ld(&(bar)[XB_TMO])) break; if (_sp > XB_SPIN_CAP) { atomicAdd(&(bar)[XB_TMO], 1u); break; } } } } while (0)

struct XcdBarrier { unsigned* bar; unsigned x; volatile LAS unsigned* st; };

__device__ __forceinline__ XcdBarrier xcd_barrier_post(unsigned* bar, volatile LAS unsigned* st) {
    XcdBarrier b; b.bar = bar; b.x = xb_xcc_id(); b.st = st;
    if (threadIdx.x == 0) (void)xb_add(&bar[XB_XCNT(b.x)], 1u);
    return b;
}
__device__ __forceinline__ void xcd_barrier_complete(unsigned* bar, unsigned x, unsigned& nloc, unsigned& nx) {
    const unsigned G = gridDim.x * gridDim.y * gridDim.z;
    unsigned sum, cnt, mine, sp = 0u;
    for (;;) {
        sum = 0u; cnt = 0u; mine = 0u;
#pragma unroll
        for (unsigned j = 0; j < 16; ++j) { const unsigned c = xb_ld(&bar[XB_XCNT(j)]); sum += c; cnt += (c > 0u) ? 1u : 0u; mine = (j == x) ? c : mine; }
        if (sum == G) break;
        __builtin_amdgcn_s_sleep(1);
        if ((++sp & 255u) == 0u) { if (xb_ld(&bar[XB_TMO])) break; if (sp > XB_SPIN_CAP) { atomicAdd(&bar[XB_TMO], 1u); break; } }
    }
    nloc = mine > 0u ? mine : 1u; nx = cnt > 0u ? cnt : 1u;
}
__device__ __forceinline__ void xcd_barrier(const XcdBarrier& b) {
    asm volatile("s_waitcnt vmcnt(0)" ::: "memory");
    __syncthreads();
    if (threadIdx.x == 0) {
        unsigned* bar = b.bar;
        __builtin_amdgcn_s_waitcnt(0);
        unsigned nloc = b.st[0], nx = b.st[1];
        if (nloc == 0u) { xcd_barrier_complete(bar, b.x, nloc, nx); b.st[0] = nloc; b.st[1] = nx; }
        const unsigned old = xb_add(&bar[XB_XSUB(b.x)], 1u);
        const unsigned gen = old / nloc;
        if (old + 1u == (gen + 1u) * nloc) {
            __builtin_amdgcn_fence(__ATOMIC_RELEASE, "agent");
            asm volatile("s_waitcnt vmcnt(0)" ::: "memory");
            const unsigned og = xb_add(&bar[XB_TOP], 1u);
            const unsigned tg = og / nx;
            if (og + 1u == (tg + 1u) * nx) xb_add(&bar[XB_TOPGEN], 1u);
            else XB_SPIN(xb_ld(&bar[XB_TOPGEN]) == tg, bar);
            __builtin_amdgcn_fence(__ATOMIC_ACQUIRE, "agent");
            xb_add(&bar[XB_XGEN(b.x)], 1u);
            asm volatile("s_waitcnt vmcnt(0)" ::: "memory");
        } else {
            XB_SPIN(xb_ld(&bar[XB_XGEN(b.x)]) == gen, bar);
            __builtin_amdgcn_fence(__ATOMIC_ACQUIRE, "agent");
            asm volatile("s_waitcnt vmcnt(0)" ::: "memory");
        }
    }
    __syncthreads();
}

enum { I_X = 0, I_C, I_CTX, I_CCTX, I_MODW, I_MODB, I_NMIX, I_NFFN, I_NFIN, I_EVWIN, I_EVWOUT, I_WAF, I_BAF, I_WAB, I_BAB, I_GLAN,
       I_HYCW, I_HYCB, I_HYW1, I_HYB1, I_HYF1, I_HYW2, I_HYB2, I_HYF2, I_HYW3, I_HYSKIP, I_ODWIN, I_ODCW, I_ODWOUT,
       I_RTWG, I_RTBG, I_RTWE, I_RTBE, I_EXW1, I_EXW3, I_EXW2, N_IN };
struct Args { const float* in[N_IN]; float* out; unsigned char* ws; int ph_lo, ph_hi, fused, pad; };

struct Frame {
    LAS unsigned char* lds;
    volatile LAS unsigned* MISC;
    int tid, lane, wave, G, bid, z;
    unsigned char* ws;
};

namespace pg8 {
constexpr int BM = 256, BK = 64, HALF = 128, HTB = HALF * BK * 2, STAGE_BYTES = 8 * HTB, NXCD = 8, WGM = 8;
__device__ __forceinline__ int lds_byte(int r, int c) { const int st = (r >> 4) * 2 + (c >> 5), rr = r & 15, cc = c & 31, ob = rr * 64 + cc * 2; return st * 1024 + (ob ^ (((ob >> 9) & 1) << 5)); }
__device__ __forceinline__ void stage_rc(int b, int& R, int& C) { const int st = b / 1024, sb = b % 1024, swz = sb ^ (((sb >> 9) & 1) << 5); R = (st >> 1) * 16 + swz / 64; C = (st & 1) * 32 + (swz % 64) / 2; }
__device__ __forceinline__ int perm32(int rho) { const int n = rho >> 4, i = rho & 15; return 8 * (i >> 2) + 4 * n + (i & 3); }
__device__ __forceinline__ unsigned cvt_pk_bf16(float lo, float hi) { return pk2(lo, hi); }

struct Unit { const char* A; const char* B; int pm, pn; };
__device__ __forceinline__ bool order_next(int i, int G, int c, int nM, int nN, int& pm, int& pn) {
    const int nwg = nM * nN; const long L = (long)i * G + c; if (L >= nwg) return false;
    int wgid = (int)L; { const int q = nwg / NXCD, r = nwg % NXCD, xcd = wgid % NXCD, off = wgid / NXCD; wgid = (xcd < r ? xcd * (q + 1) : r * (q + 1) + (xcd - r) * q) + off; }
    const int nig = WGM * nN, gid = wgid / nig, fm = gid * WGM, gsz = (nM - fm) < WGM ? (nM - fm) : WGM;
    pm = fm + ((wgid % nig) % gsz); pn = (wgid % nig) / gsz; return true;
}

typedef int i32x8 __attribute__((ext_vector_type(8)));
typedef int i32x4 __attribute__((ext_vector_type(4)));
__device__ __forceinline__ i32x8 cat8(bf16x8 a, bf16x8 b) { const i32x4 x = __builtin_bit_cast(i32x4, a), y = __builtin_bit_cast(i32x4, b); return __builtin_shufflevector(x, y, 0, 1, 2, 3, 4, 5, 6, 7); }
template <class P>
__device__ __forceinline__ void gemm_phase(LAS unsigned char* lds, const P& pr, const int tid) {
    const int wid = __builtin_amdgcn_readfirstlane(tid >> 6), lane = tid & 63, wr = wid >> 2, wc = wid & 3, fr = lane & 15, fq = lane >> 4;
    const int KB = P::FP8 ? pr.K : 2 * pr.K;
    const int nt = KB / 128;
    unsigned voffB[2], Rr[2], Cb[2];
#pragma unroll
    for (int i = 0; i < 2; ++i) { int R, C; stage_rc(tid * 16 + i * 8192, R, C);
        const int Rb = P::PERM16 ? (64 * (R >> 5) + 16 * ((R & 15) >> 2) + 4 * ((R >> 4) & 1) + (R & 3)) : (P::PERM ? ((R & ~31) + perm32(R & 31)) : R);
        voffB[i] = (unsigned)(Rb * KB + C * 2); Rr[i] = (unsigned)R; Cb[i] = (unsigned)C * 2u; }
    const size_t kstep = (size_t)128;
    const size_t hstep = (size_t)(P::PERM16 ? 8 : HALF) * KB;
    const unsigned ldsw = (unsigned)wid * 1024u;
    const int aoff = lds_byte(wr * 64 + fr, fq * 8), boff = lds_byte(wc * 32 + fr, fq * 8);
#define PG8_SA(b, h) (((b) * 2 + (h)) * HTB)
#define PG8_SB(b, h) ((4 + (b) * 2 + (h)) * HTB)
#define PG8_STAGE(bufoff, gbase, voff) do { const char* _gb = (const char*)(gbase); asm volatile("" : "+s"(_gb)); _Pragma("unroll") for (int _i = 0; _i < 2; ++_i) \
        __builtin_amdgcn_global_load_lds((const unsigned*)(_gb + (voff)[_i]), (LAS unsigned*)(lds + (bufoff) + ldsw + _i * 8192), 16, 0, 0); } while (0)
#define PG8_LDA(dst, b, h) do { _Pragma("unroll") for (int m = 0; m < 4; ++m) _Pragma("unroll") for (int k = 0; k < 2; ++k) dst[m][k] = *(const LAS bf16x8*)(lds + PG8_SA(b, h) + aoff + m * 2048 + k * 1024); } while (0)
#define PG8_LDB(dst, b, h) do { _Pragma("unroll") for (int n = 0; n < 2; ++n) _Pragma("unroll") for (int k = 0; k < 2; ++k) dst[n][k] = *(const LAS bf16x8*)(lds + PG8_SB(b, h) + boff + n * 2048 + k * 1024); } while (0)
#define PG8_MMA(ai, bj, At, Bt) do { __builtin_amdgcn_s_setprio(1); _Pragma("unroll") for (int m = 0; m < 4; ++m) _Pragma("unroll") for (int n = 0; n < 2; ++n) { \
        if constexpr (P::FP8) { const i32x8 _w = cat8(Bt[n][0], Bt[n][1]), _x = cat8(At[m][0], At[m][1]); \
            asm volatile("v_mfma_scale_f32_16x16x128_f8f6f4 %0, %1, %2, %0, %3, %4 op_sel_hi:[0,0,0]" : "+v"(acc[ai][bj][m][n]) : "v"(_w), "v"(_x), "v"((bj) ? scw1_ : scw_), "v"(scx_)); } \
        else { _Pragma("unroll") for (int k = 0; k < 2; ++k) acc[ai][bj][m][n] = __builtin_amdgcn_mfma_f32_16x16x32_bf16(Bt[n][k], At[m][k], acc[ai][bj][m][n], 0, 0, 0); } } \
        __builtin_amdgcn_s_setprio(0); } while (0)
#define PG8_WAIT_V(n) asm volatile("s_waitcnt vmcnt(" #n ")" ::: "memory")
#define PG8_WAIT_L(n) asm volatile("s_waitcnt lgkmcnt(" #n ")" ::: "memory")
#define PG8_BAR __builtin_amdgcn_s_barrier()
#define PG8_SCHED __builtin_amdgcn_sched_barrier(0)
    int scw_ = P::SCW, scw1_ = P::SCW1, scx_ = P::SCX; asm volatile("" : "+v"(scw_), "+v"(scw1_), "+v"(scx_));
    Unit cur, nxt; int ui = 0;
    if (!pr.next(0, cur)) return;
    unsigned vc[2][2], vn[2][2];
#pragma unroll
    for (int h = 0; h < 2; ++h)
#pragma unroll
        for (int i = 0; i < 2; ++i) {
            if constexpr (P::GATHER) vc[h][i] = pr.row_id(cur, h * HALF + (int)Rr[i]) * (unsigned)KB + Cb[i];
            else vc[h][i] = (unsigned)((h * HALF + (int)Rr[i]) * KB) + Cb[i];
            vn[h][i] = vc[h][i];
        }
    f32x4 acc[2][2][4][2];
#pragma unroll
    for (int a = 0; a < 2; ++a)
#pragma unroll
        for (int b = 0; b < 2; ++b)
#pragma unroll
            for (int m = 0; m < 4; ++m)
#pragma unroll
                for (int n = 0; n < 2; ++n) acc[a][b][m][n] = (f32x4){0.f, 0.f, 0.f, 0.f};
    bf16x8 At[4][2], B0[2][2], B1[2][2];
    const char* cA = cur.A; const char* cB = cur.B;
    PG8_STAGE(PG8_SB(0, 0), cB, voffB); PG8_STAGE(PG8_SA(0, 0), cA, vc[0]); PG8_STAGE(PG8_SB(0, 1), cB + hstep, voffB); PG8_STAGE(PG8_SA(0, 1), cA, vc[1]);
    if (wr == 1) PG8_BAR;
    PG8_WAIT_V(4); PG8_BAR;
    PG8_STAGE(PG8_SB(1, 0), cB + kstep, voffB); PG8_STAGE(PG8_SA(1, 0), cA + kstep, vc[0]); PG8_STAGE(PG8_SB(1, 1), cB + hstep + kstep, voffB);
    PG8_WAIT_V(6); PG8_BAR;
    unsigned nid[2][2] = {{0u, 0u}, {0u, 0u}};
    for (;;) {
        const bool has_next = pr.next(ui + 1, nxt);
        const char* nA = has_next ? nxt.A : cA; const char* nB = has_next ? nxt.B : cB;
        for (int t = 0; t < nt; t += 2) {
            const bool last = (t == nt - 2);
            if constexpr (P::GATHER) {
                LAS unsigned* mbox = (LAS unsigned*)(lds + STAGE_BYTES) + wid * 256;
                if (has_next && t == nt - 4) {
#pragma unroll
                    for (int h = 0; h < 2; ++h)
#pragma unroll
                        for (int i = 0; i < 2; ++i) __builtin_amdgcn_global_load_lds((const unsigned*)pr.row_id_ptr(nxt, h * HALF + (int)Rr[i]), mbox + (h * 2 + i) * 64, 4, 0, 0);
                }
                if (has_next && last) {
#pragma unroll
                    for (int h = 0; h < 2; ++h)
#pragma unroll
                        for (int i = 0; i < 2; ++i) { nid[h][i] = mbox[(h * 2 + i) * 64 + lane]; vn[h][i] = nid[h][i] * (unsigned)KB + Cb[i]; }
                }
            }
            unsigned v2[2][2];
#pragma unroll
            for (int h = 0; h < 2; ++h)
#pragma unroll
                for (int i = 0; i < 2; ++i) v2[h][i] = last ? vn[h][i] : vc[h][i];
            const char* a1 = cA + (size_t)(t + 1) * kstep;
            const char* a2 = last ? nA : cA + (size_t)(t + 2) * kstep; const char* b2 = last ? nB : cB + (size_t)(t + 2) * kstep;
            const char* a3 = a2 + kstep; const char* b3 = b2 + kstep;
            PG8_LDB(B0, 0, 0); PG8_SCHED; PG8_LDA(At, 0, 0); PG8_STAGE(PG8_SA(1, 1), a1, vc[1]);
            PG8_WAIT_L(8); PG8_BAR; PG8_WAIT_L(0); PG8_MMA(0, 0, At, B0); PG8_BAR; PG8_SCHED;
            PG8_LDB(B1, 0, 1); PG8_STAGE(PG8_SB(0, 0), b2, voffB);
            PG8_BAR; PG8_WAIT_L(0); PG8_MMA(0, 1, At, B1); PG8_BAR;
            PG8_LDA(At, 0, 1); PG8_STAGE(PG8_SA(0, 0), a2, v2[0]);
            PG8_BAR; PG8_WAIT_L(0); PG8_MMA(1, 0, At, B0); PG8_BAR; PG8_SCHED;
            PG8_STAGE(PG8_SB(0, 1), b2 + hstep, voffB);
            PG8_WAIT_V(6); PG8_BAR; PG8_MMA(1, 1, At, B1); PG8_BAR;
            PG8_LDB(B0, 1, 0); PG8_SCHED; PG8_LDA(At, 1, 0); PG8_STAGE(PG8_SA(0, 1), a2, v2[1]);
            PG8_WAIT_L(8); PG8_BAR; PG8_WAIT_L(0); PG8_MMA(0, 0, At, B0); PG8_BAR; PG8_SCHED;
            PG8_LDB(B1, 1, 1); PG8_STAGE(PG8_SB(1, 0), b3, voffB);
            PG8_BAR; PG8_WAIT_L(0); PG8_MMA(0, 1, At, B1); PG8_BAR;
            PG8_LDA(At, 1, 1); PG8_STAGE(PG8_SA(1, 0), a3, v2[0]);
            PG8_BAR; PG8_WAIT_L(0); PG8_MMA(1, 0, At, B0); PG8_BAR; PG8_SCHED;
            PG8_STAGE(PG8_SB(1, 1), b3 + hstep, voffB);
            PG8_WAIT_V(6); PG8_BAR; PG8_MMA(1, 1, At, B1); PG8_BAR;
        }
        if constexpr (P::FP8) asm volatile("s_nop 7\n\ts_nop 7\n\ts_nop 3" ::: "memory");
        { int zz; asm volatile("s_mov_b32 %0, 0" : "=s"(zz));
          pr.epi(acc, cur, wr, wc, fr + zz, fq); }
        if (!has_next) break;
#pragma unroll
        for (int a = 0; a < 2; ++a)
#pragma unroll
            for (int b = 0; b < 2; ++b)
#pragma unroll
                for (int m = 0; m < 4; ++m)
#pragma unroll
                    for (int n = 0; n < 2; ++n) acc[a][b][m][n] = (f32x4){0.f, 0.f, 0.f, 0.f};
        cur = nxt; cA = nA; cB = nB; ++ui;
#pragma unroll
        for (int h = 0; h < 2; ++h)
#pragma unroll
            for (int i = 0; i < 2; ++i) vc[h][i] = vn[h][i];
    }
    PG8_WAIT_V(0);
    if (wr == 0) PG8_BAR;
    PG8_BAR;
#undef PG8_SA
#undef PG8_SB
#undef PG8_STAGE
#undef PG8_LDA
#undef PG8_LDB
#undef PG8_MMA
#undef PG8_WAIT_V
#undef PG8_WAIT_L
#undef PG8_BAR
#undef PG8_SCHED
}
}

struct ProbIn {
    static constexpr bool PERM = true, PERM16 = false, GATHER = false, FP8 = false; static constexpr int SCW = 0, SCW1 = 0, SCX = 0;
    const bf16_t* A; const bf16_t* Bt; bf16_t* O; int K, nM, nN, ncols, ldc, row0, G, c;
    int prod0;
    bf16_t* Gd; const float* gbf; const float* gbb;
    __device__ __forceinline__ bool next(int i, pg8::Unit& u) const {
        if (!pg8::order_next(i, G, c, nM, nN, u.pm, u.pn)) return false;
        u.A = (const char*)(A + (size_t)(row0 + u.pm * 256) * K); u.B = (const char*)(Bt + (size_t)(u.pn * 256) * K); return true; }
    __device__ __forceinline__ unsigned row_id(const pg8::Unit&, int) const { return 0u; }
    __device__ __forceinline__ const int* row_id_ptr(const pg8::Unit&, int) const { return nullptr; }
    __device__ __forceinline__ void epi(const f32x4 (&acc)[2][2][4][2], const pg8::Unit& u, int wr, int wc, int fr, int fq) const {
        const int rowb = row0 + u.pm * 256 + wr * 64 + fr, colb = u.pn * 256 + wc * 32 + 8 * fq;
        if (u.pn * 256 >= prod0) {
            const int col = prod0 + (u.pn - (prod0 >> 8)) * 128 + wc * 32 + 8 * fq;
#pragma unroll
            for (int ai = 0; ai < 2; ++ai)
#pragma unroll
                for (int m = 0; m < 4; ++m) { const f32x4 a0 = acc[ai][0][m][0] * acc[ai][1][m][0], a1 = acc[ai][0][m][1] * acc[ai][1][m][1];
                    u32x4 w; w.x = pg8::cvt_pk_bf16(a0[0], a0[1]); w.y = pg8::cvt_pk_bf16(a0[2], a0[3]); w.z = pg8::cvt_pk_bf16(a1[0], a1[1]); w.w = pg8::cvt_pk_bf16(a1[2], a1[3]);
                    *(u32x4*)(O + (size_t)(rowb + ai * 128 + m * 16) * ldc + col) = w; }
        } else if (colb < ncols) {
            const char* tb = (const char*)(O + (size_t)(row0 + u.pm * 256) * ldc + u.pn * 256);
            const unsigned lo0 = (unsigned)((wr * 64 + fr) * ldc + wc * 32 + 8 * fq) * 2u; const unsigned rstep = (unsigned)ldc * 32u;
#pragma unroll
            for (int ai = 0; ai < 2; ++ai)
#pragma unroll
                for (int m = 0; m < 4; ++m) { const unsigned ro = lo0 + (unsigned)(ai * 8 + m) * rstep;
#pragma unroll
                    for (int bj = 0; bj < 2; ++bj) { const f32x4 v0 = acc[ai][bj][m][0], v1 = acc[ai][bj][m][1];
                        u32x4 w; w.x = pg8::cvt_pk_bf16(v0[0], v0[1]); w.y = pg8::cvt_pk_bf16(v0[2], v0[3]); w.z = pg8::cvt_pk_bf16(v1[0], v1[1]); w.w = pg8::cvt_pk_bf16(v1[2], v1[3]);
                        *(u32x4*)(tb + (ro + (unsigned)bj * 256u)) = w; } }
        } else {
            const int gc = colb - ncols;
            const float* bp = (gc < 256) ? gbf + gc : gbb + (gc - 256);
            f32x4 bv[2][2];
#pragma unroll
            for (int bj = 0; bj < 2; ++bj)
#pragma unroll
                for (int n = 0; n < 2; ++n) bv[bj][n] = *(const f32x4*)(bp + bj * 128 + 4 * n);
#pragma unroll
            for (int ai = 0; ai < 2; ++ai)
#pragma unroll
                for (int m = 0; m < 4; ++m) { bf16_t* rowp = Gd + (size_t)(rowb + ai * 128 + m * 16) * 512 + gc;
#pragma unroll
                    for (int bj = 0; bj < 2; ++bj) { float o[8];
#pragma unroll
                        for (int n = 0; n < 2; ++n)
#pragma unroll
                            for (int j = 0; j < 4; ++j) { const float z = acc[ai][bj][m][n][j] + bv[bj][n][j]; o[n * 4 + j] = (fminf(z, 0.f) - __logf(1.0f + __expf(-fabsf(z)))) * (1.0f / 16.0f); }
                        u32x4 w; w.x = pg8::cvt_pk_bf16(o[0], o[1]); w.y = pg8::cvt_pk_bf16(o[2], o[3]); w.z = pg8::cvt_pk_bf16(o[4], o[5]); w.w = pg8::cvt_pk_bf16(o[6], o[7]);
                        *(u32x4*)(rowp + bj * 128) = w; } }
        }
    }
};
template <bool F8> struct ProbOut {
    static constexpr bool PERM = true, PERM16 = false, GATHER = false, FP8 = F8; static constexpr int SCW = E8_WO, SCW1 = E8_WO, SCX = E8_Z;
    const unsigned char* A; const unsigned char* Bt; int K, nM, nN, row0, G, c;
    const float* x_c; const float* x_l; int first; bf16_t* H16; const float* gate;
    __device__ __forceinline__ bool next(int i, pg8::Unit& u) const {
        if (!pg8::order_next(i, G, c, nM, nN, u.pm, u.pn)) return false;
        constexpr int EB = F8 ? 1 : 2;
        u.A = (const char*)(A + (size_t)(row0 + u.pm * 256) * K * EB); u.B = (const char*)(Bt + (size_t)(u.pn * 256) * K * EB); return true; }
    __device__ __forceinline__ unsigned row_id(const pg8::Unit&, int) const { return 0u; }
    __device__ __forceinline__ const int* row_id_ptr(const pg8::Unit&, int) const { return nullptr; }
    __device__ __forceinline__ void epi(const f32x4 (&acc)[2][2][4][2], const pg8::Unit& u, int wr, int wc, int fr, int fq) const {
        const int tile0 = row0 + u.pm * 256;
        const int b = tile0 < RC ? NB : ((tile0 - RC) >> 11);
        const float* xs = tile0 < RC ? x_c + (size_t)tile0 * D : x_l + (size_t)(tile0 - RC) * D;
        bf16_t* hp = H16 + (size_t)tile0 * D;
        const int col0 = u.pn * 256 + wc * 32 + 8 * fq; const float* gp = gate + (size_t)b * 6144 + col0;
        f32x4 gv[2][2];
#pragma unroll
        for (int bj = 0; bj < 2; ++bj)
#pragma unroll
            for (int n = 0; n < 2; ++n) gv[bj][n] = *(const f32x4*)(gp + bj * 128 + 4 * n);
        if (!first) {
#pragma unroll
            for (int ai = 0; ai < 2; ++ai) {
                u32x4 hw[4][2];
#pragma unroll
                for (int m = 0; m < 4; ++m)
#pragma unroll
                    for (int bj = 0; bj < 2; ++bj) hw[m][bj] = *(const u32x4*)(hp + (size_t)(wr * 64 + fr + ai * 128 + m * 16) * D + col0 + bj * 128);
                __builtin_amdgcn_sched_barrier(0);
#pragma unroll
                for (int m = 0; m < 4; ++m) { const size_t off = (size_t)(wr * 64 + fr + ai * 128 + m * 16) * D + col0;
#pragma unroll
                    for (int bj = 0; bj < 2; ++bj) { const u32x4 w = hw[m][bj];
                        f32x4 s0 = (f32x4){bflo(w.x), bfhi(w.x), bflo(w.y), bfhi(w.y)}, s1 = (f32x4){bflo(w.z), bfhi(w.z), bflo(w.w), bfhi(w.w)};
                        s0 = s0 + gv[bj][0] * acc[ai][bj][m][0]; s1 = s1 + gv[bj][1] * acc[ai][bj][m][1];
                        u32x4 o; o.x = pg8::cvt_pk_bf16(s0[0], s0[1]); o.y = pg8::cvt_pk_bf16(s0[2], s0[3]); o.z = pg8::cvt_pk_bf16(s1[0], s1[1]); o.w = pg8::cvt_pk_bf16(s1[2], s1[3]);
                        *(u32x4*)(hp + off + bj * 128) = o; } }
                __builtin_amdgcn_sched_barrier(0);
            }
        } else {
#pragma unroll
            for (int am = 0; am < 4; ++am) { const int ai = am >> 1, m0 = (am & 1) * 2;
                f32x4 xw[2][2][2];
#pragma unroll
                for (int mm = 0; mm < 2; ++mm)
#pragma unroll
                    for (int bj = 0; bj < 2; ++bj) { const float* xp = xs + (size_t)(wr * 64 + fr + ai * 128 + (m0 + mm) * 16) * D + col0 + bj * 128; xw[mm][bj][0] = *(const f32x4*)xp; xw[mm][bj][1] = *(const f32x4*)(xp + 4); }
                __builtin_amdgcn_sched_barrier(0);
#pragma unroll
                for (int mm = 0; mm < 2; ++mm) { const int m = m0 + mm; const size_t off = (size_t)(wr * 64 + fr + ai * 128 + m * 16) * D + col0;
#pragma unroll
                    for (int bj = 0; bj < 2; ++bj) {
                        const f32x4 s0 = xw[mm][bj][0] + gv[bj][0] * acc[ai][bj][m][0], s1 = xw[mm][bj][1] + gv[bj][1] * acc[ai][bj][m][1];
                        u32x4 o; o.x = pg8::cvt_pk_bf16(s0[0], s0[1]); o.y = pg8::cvt_pk_bf16(s0[2], s0[3]); o.z = pg8::cvt_pk_bf16(s1[0], s1[1]); o.w = pg8::cvt_pk_bf16(s1[2], s1[3]);
                        *(u32x4*)(hp + off + bj * 128) = o; } }
                __builtin_amdgcn_sched_barrier(0);
            }
        }
    }
};
struct ProbMoe1 {
    static constexpr bool PERM = true, PERM16 = false, GATHER = true, FP8 = true; static constexpr int SCW = E8_W13, SCW1 = E8_W13G, SCX = E8_V;
    const unsigned char* A; const unsigned char* W13; unsigned char* H; const int* toks; int K, ntiles, G, c;
    const volatile LAS unsigned* misc;
    __device__ __forceinline__ bool next(int i, pg8::Unit& u) const {
        if (!pg8::order_next(i, G, c, ntiles, 4, u.pm, u.pn)) return false;
        const int e = __builtin_amdgcn_readfirstlane((int)misc[MW_TILE + u.pm]);
        u.A = (const char*)A; u.B = (const char*)(W13 + ((size_t)e * 1024 + u.pn * 256) * 1024); return true; }
    __device__ __forceinline__ unsigned row_id(const pg8::Unit& u, int r) const {
        const int e = __builtin_amdgcn_readfirstlane((int)misc[MW_TILE + u.pm]); const int r0 = (u.pm - __builtin_amdgcn_readfirstlane((int)misc[MW_TSTART + e])) * 256; const int cnt = __builtin_amdgcn_readfirstlane((int)misc[MW_CNT + e]);
        int idx = r0 + r; idx = idx < cnt ? idx : cnt - 1;
        return (unsigned)toks[(size_t)e * RT + idx]; }
    __device__ __forceinline__ const int* row_id_ptr(const pg8::Unit& u, int r) const {
        const int e = __builtin_amdgcn_readfirstlane((int)misc[MW_TILE + u.pm]); const int r0 = (u.pm - __builtin_amdgcn_readfirstlane((int)misc[MW_TSTART + e])) * 256; const int cnt = __builtin_amdgcn_readfirstlane((int)misc[MW_CNT + e]);
        int idx = r0 + r; idx = idx < cnt ? idx : cnt - 1;
        return toks + (size_t)e * RT + idx; }
    __device__ __forceinline__ void epi(const f32x4 (&acc)[2][2][4][2], const pg8::Unit& u, int wr, int wc, int fr, int fq) const {
        const int rowb = u.pm * 256 + wr * 64 + fr, col = u.pn * 128 + wc * 32 + 8 * fq;
#pragma unroll
        for (int ai = 0; ai < 2; ++ai)
#pragma unroll
            for (int m = 0; m < 4; ++m) { unsigned char* rowp = H + (size_t)(rowb + ai * 128 + m * 16) * DE + col;
                float o[8];
#pragma unroll
                for (int n = 0; n < 2; ++n)
#pragma unroll
                    for (int j = 0; j < 4; j += 2) { const f32x2 a2 = {acc[ai][0][m][n][j], acc[ai][0][m][n][j + 1]}, g2 = {acc[ai][1][m][n][j], acc[ai][1][m][n][j + 1]};
                        const f32x2 t2 = a2 * (-1.44269504089f);
                        f32x2 r2; r2.x = __builtin_amdgcn_rcpf(1.0f + __builtin_amdgcn_exp2f(t2.x)); r2.y = __builtin_amdgcn_rcpf(1.0f + __builtin_amdgcn_exp2f(t2.y));
                        const f32x2 o2 = (a2 * r2) * g2; o[n * 4 + j] = o2.x; o[n * 4 + j + 1] = o2.y; }
                u32x2 w; w.x = pk4_fp8(o[0], o[1], o[2], o[3]); w.y = pk4_fp8(o[4], o[5], o[6], o[7]);
                *(u32x2*)rowp = w; }
    }
};
struct ProbMoe2 {
    static constexpr bool PERM = true, PERM16 = true, GATHER = false, FP8 = true; static constexpr int SCW = E8_W2Y, SCW1 = E8_W2Y, SCX = E8_H;
    const unsigned char* Hb; const unsigned char* W2T; unsigned char* Y; int K, ntiles, G, c;
    const volatile LAS unsigned* misc;
    __device__ __forceinline__ bool next(int i, pg8::Unit& u) const {
        if (!pg8::order_next(i, G, c, ntiles, 4, u.pm, u.pn)) return false;
        const int e = __builtin_amdgcn_readfirstlane((int)misc[MW_TILE + u.pm]);
        u.A = (const char*)(Hb + (size_t)u.pm * 256 * DE); u.B = (const char*)(W2T + ((size_t)e * 1024 + u.pn * 256) * DE); return true; }
    __device__ __forceinline__ unsigned row_id(const pg8::Unit&, int) const { return 0u; }
    __device__ __forceinline__ const int* row_id_ptr(const pg8::Unit&, int) const { return nullptr; }
    __device__ __forceinline__ void epi(const f32x4 (&acc)[2][2][4][2], const pg8::Unit& u, int wr, int wc, int fr, int fq) const {
        const int rowb = u.pm * 256 + wr * 64 + fr, colb = u.pn * 256 + wc * 64 + 16 * fq;
#pragma unroll
        for (int ai = 0; ai < 2; ++ai)
#pragma unroll
            for (int m = 0; m < 4; ++m) { unsigned char* rowp = Y + (size_t)(rowb + ai * 128 + m * 16) * D;
                u32x4 w;
                { const f32x4 v0 = acc[ai][0][m][0], v1 = acc[ai][0][m][1], v2 = acc[ai][1][m][0], v3 = acc[ai][1][m][1];
                  w.x = pk4_fp8(v0[0], v0[1], v0[2], v0[3]); w.y = pk4_fp8(v1[0], v1[1], v1[2], v1[3]); w.z = pk4_fp8(v2[0], v2[1], v2[2], v2[3]); w.w = pk4_fp8(v3[0], v3[1], v3[2], v3[3]); }
                *(u32x4*)(rowp + colb) = w; }
    }
};

__device__ __forceinline__ void transpose_tile(const float* W, int ldw, bf16_t* dst, int ldd, LAS float* scr, int lane) {
#pragma unroll 8
    for (int i = 0; i < 32; ++i) { const int kk = 2 * i + (lane >> 5); scr[kk * 33 + (lane & 31)] = W[(size_t)kk * ldw + (lane & 31)]; }
    LDS_WAIT(); asm volatile("" ::: "memory");
    const int c = lane & 7;
#pragma unroll
    for (int j = 0; j < 4; ++j) { const int n = (lane >> 3) + 8 * j; const LAS float* s = scr + (8 * c) * 33 + n;
        u32x4 o; o.x = pk2(s[0 * 33], s[1 * 33]); o.y = pk2(s[2 * 33], s[3 * 33]); o.z = pk2(s[4 * 33], s[5 * 33]); o.w = pk2(s[6 * 33], s[7 * 33]);
        *(u32x4*)(dst + (size_t)n * ldd + 8 * c) = o; }
    LDS_WAIT(); asm volatile("" ::: "memory");
}
__device__ __forceinline__ void transpose_item(const float* W, int K, int N, bf16_t* WT, LAS float* scr, int it, int lane) {
    const int nblk = N / 32, kb = it / nblk, nb = it % nblk;
    transpose_tile(W + (size_t)(kb * 64) * N + nb * 32, N, WT + (size_t)(nb * 32) * K + kb * 64, K, scr, lane);
}

__device__ __forceinline__ void tile_load(float (&r)[32], const float* W, int ldw, int lane) {
#pragma unroll
    for (int i = 0; i < 32; ++i) { const int kk = 2 * i + (lane >> 5); r[i] = W[(size_t)kk * ldw + (lane & 31)]; }
}
__device__ __forceinline__ void tile_store8(const float (&r)[32], unsigned char* dst, int ldd, float sc, LAS float* scr, int lane) {
#pragma unroll
    for (int i = 0; i < 32; ++i) { const int kk = 2 * i + (lane >> 5); scr[kk * 33 + (lane & 31)] = r[i]; }
    LDS_WAIT(); asm volatile("" ::: "memory");
    const int c = lane & 7;
#pragma unroll
    for (int j = 0; j < 4; ++j) { const int n = (lane >> 3) + 8 * j; const LAS float* s = scr + (8 * c) * 33 + n;
        u32x2 o; o.x = pk4_fp8(s[0 * 33] * sc, s[1 * 33] * sc, s[2 * 33] * sc, s[3 * 33] * sc); o.y = pk4_fp8(s[4 * 33] * sc, s[5 * 33] * sc, s[6 * 33] * sc, s[7 * 33] * sc);
        *(u32x2*)(dst + (size_t)n * ldd + 8 * c) = o; }
    LDS_WAIT(); asm volatile("" ::: "memory");
}
__device__ __forceinline__ void phase_pre(const Args& a, Frame& F) {
    unsigned char* ws = F.ws;
    LAS float* scr = (LAS float*)(F.lds + F.wave * 16384);
    const int gw = F.bid * 8 + F.wave, NGW = F.G * 8;
    {
        constexpr int I_EI = 16 * (EVSRC / 32), I_SQ = 16 * 32, I_OI = 16 * (ODN / 32);
        constexpr int NIT = 2 * (I_EI + I_SQ + I_OI + I_SQ);
        for (int it = gw; it < NIT; it += NGW) {
            int r = it; const int i = r & 1; r >>= 1;
            if (r < I_EI) { const int nblk = EVSRC / 32, kb = r / nblk, nb = r % nblk; const int n0 = nb * 32;
                if (n0 != 1536) { const int drow = n0 < 1536 ? n0 : n0 - 32;
                    transpose_tile(a.in[F.z + I_EVWIN] + (size_t)i * D * EVSRC + (size_t)(kb * 64) * EVSRC + n0, EVSRC, (bf16_t*)(ws + WS_WEVIN) + (size_t)i * EVNP * D + (size_t)drow * D + kb * 64, D, scr, F.lane); }
                continue; } r -= I_EI;
            if (r < I_SQ) { transpose_item(a.in[F.z + I_EVWOUT] + (size_t)i * D * D, D, D, (bf16_t*)(ws + WS_WEVOUT) + (size_t)i * D * D, scr, r, F.lane); continue; } r -= I_SQ;
            if (r < I_OI) { const int nblk = ODN / 32, kb = r / nblk, nb = r % nblk; const int n0 = nb * 32;
                const int drow = n0 < 1024 ? n0 : (n0 < 2048 ? 1024 + ((n0 - 1024) >> 7) * 256 + ((n0 - 1024) & 127) : 1024 + ((n0 - 2048) >> 7) * 256 + 128 + ((n0 - 2048) & 127));
                transpose_tile(a.in[F.z + I_ODWIN] + (size_t)i * D * ODN + (size_t)(kb * 64) * ODN + n0, ODN, (bf16_t*)(ws + WS_WODIN) + (size_t)i * ODN * D + (size_t)drow * D + kb * 64, D, scr, F.lane);
                continue; } r -= I_OI;
            { const int kb = r >> 5, nb = r & 31; float tr_[32];
              tile_load(tr_, a.in[F.z + I_ODWOUT] + (size_t)i * D * D + (size_t)(kb * 64) * D + nb * 32, D, F.lane);
              tile_store8(tr_, ws + WS_WODOUT + (size_t)i * D * D + (size_t)(nb * 32) * D + kb * 64, D, SC_WO, scr, F.lane); }
        }
        for (int idx = F.bid * 512 + F.tid; idx < 2 * 512 * D; idx += F.G * 512) {
            const int k = idx & 1023, n = (idx >> 10) & 511, i = idx >> 19; const int dir = n >> 8, nn = n & 255;
            const float* wr = a.in[F.z + I_EVWIN] + ((size_t)i * D + k) * EVSRC + 1536 + 16 * dir; const float* wa = a.in[F.z + (dir ? I_WAB : I_WAF)] + (size_t)i * 16 * 256 + nn;
            float sacc = 0.f;
#pragma unroll
            for (int r = 0; r < 16; ++r) sacc += wr[r] * wa[r * 256];
            ((bf16_t*)(ws + WS_WEVIN))[(size_t)i * EVNP * D + (size_t)(3072 + n) * D + k] = (bf16_t)f2bf(sacc);
        }
    }
    {
        bf16_t* RW = (bf16_t*)(ws + WS_RW);
        for (int idx = F.bid * 512 + F.tid; idx < DEPTH * 48 * D; idx += F.G * 512) {
            const int k = idx & 1023, n = (idx >> 10) % 48, l = idx / (48 * 1024);
            float v = 0.f;
            if (n < 4) v = a.in[F.z + I_RTWG][((size_t)l * D + k) * 4 + n];
            else if (n < 36) v = a.in[F.z + I_RTWE][((size_t)l * D + k) * 32 + (n - 4)];
            RW[idx] = (bf16_t)f2bf(v);
        }
    }
    __syncthreads();
    {
        LAS float* sc = (LAS float*)F.lds;
        float* MOD = (float*)(ws + WS_MOD);
        for (int unit = F.bid; unit < DEPTH * 6144 / 128; unit += F.G) {
            for (int idx = F.tid; idx < 33 * D; idx += 512) { const int r = idx >> 10, k = idx & 1023; const float cv = r < NB ? a.in[F.z + I_C][r * D + k] : a.in[F.z + I_CCTX][k]; sc[idx] = silu_f(cv); }
            __syncthreads();
            const int col = F.tid & 127, ks = F.tid >> 7; const int gc = unit * 128 + col, l = gc / 6144, n = gc % 6144;
            const float* wp = a.in[F.z + I_MODW] + ((size_t)l * D + ks * 256) * 6144 + n;
            f32x2 acc2[33];
#pragma unroll
            for (int r = 0; r < 33; ++r) acc2[r] = (f32x2){0.f, 0.f};
            f32x2 wa01 = {wp[0], wp[(size_t)1 * 6144]}, wa23 = {wp[(size_t)2 * 6144], wp[(size_t)3 * 6144]}, wb01, wb23;
            for (int k = 0; k < 256; k += 8) {
                wb01 = (f32x2){wp[(size_t)(k + 4) * 6144], wp[(size_t)(k + 5) * 6144]}; wb23 = (f32x2){wp[(size_t)(k + 6) * 6144], wp[(size_t)(k + 7) * 6144]};
                __builtin_amdgcn_sched_barrier(0);
#pragma unroll
                for (int r = 0; r < 33; ++r) { const f32x4 s = *(const LAS f32x4*)(sc + r * D + ks * 256 + k);
                    acc2[r] = __builtin_elementwise_fma((f32x2){s[0], s[1]}, wa01, acc2[r]); acc2[r] = __builtin_elementwise_fma((f32x2){s[2], s[3]}, wa23, acc2[r]); }
                __builtin_amdgcn_sched_barrier(0);
                { const int kn = k + 8 < 256 ? k + 8 : k;
                  wa01 = (f32x2){wp[(size_t)(kn + 0) * 6144], wp[(size_t)(kn + 1) * 6144]}; wa23 = (f32x2){wp[(size_t)(kn + 2) * 6144], wp[(size_t)(kn + 3) * 6144]}; }
                __builtin_amdgcn_sched_barrier(0);
#pragma unroll
                for (int r = 0; r < 33; ++r) { const f32x4 s = *(const LAS f32x4*)(sc + r * D + ks * 256 + k + 4);
                    acc2[r] = __builtin_elementwise_fma((f32x2){s[0], s[1]}, wb01, acc2[r]); acc2[r] = __builtin_elementwise_fma((f32x2){s[2], s[3]}, wb23, acc2[r]); }
                __builtin_amdgcn_sched_barrier(0);
            }
            float acc[33];
#pragma unroll
            for (int r = 0; r < 33; ++r) acc[r] = acc2[r][0] + acc2[r][1];
            __syncthreads();
            LAS float* red = (LAS float*)F.lds;
#pragma unroll
            for (int r = 0; r < 33; ++r) red[(ks * 33 + r) * 128 + col] = acc[r];
            __syncthreads();
            for (int r = ks; r < 33; r += 4) {
                const float s = red[(0 * 33 + r) * 128 + col] + red[(1 * 33 + r) * 128 + col] + red[(2 * 33 + r) * 128 + col] + red[(3 * 33 + r) * 128 + col];
                MOD[((size_t)l * 33 + r) * 6144 + n] = s + a.in[F.z + I_MODB][l * 6144 + n];
            }
            __syncthreads();
        }
    }
    {
        LAS float* zf = (LAS float*)F.lds;
        LAS float* h1 = zf + 32 * 36;
        LAS float* h2 = h1 + 32 * 64;
        for (int it = F.G - 1 - F.bid; it < 2 * 72; it += F.G) {
            const int i = it / 72, r = it % 72; const int sel = r < 64 ? 0 : 1; const int L = sel ? LC : SEQ; const int t0 = (sel ? (r - 64) : r) * 32;
            for (int idx = F.tid; idx < 32 * 33; idx += 512) {
                const int tt = idx / 33, f = idx % 33; const int t = t0 + tt; float v;
                if (f == 0) v = (float)t / (float)(L - 1);
                else { const int k = (f - 1) & 15; const float band = 1e-4f + (float)k * ((15.0f - 1e-4f) / 15.0f);
                    const float cst = (float)(2.0 * 3.14159265358979323846 / (double)L); const float ang = (cst * (float)t) * band;
                    v = (f <= 16) ? (float)cos((double)ang) : (float)sin((double)ang); }
                zf[tt * 36 + f] = v;
            }
            __syncthreads();
            for (int idx = F.tid; idx < 32 * 64; idx += 512) { const int tt = idx >> 6, j = idx & 63; float s = a.in[F.z + I_HYB1][i * 64 + j];
                for (int f = 0; f < 33; ++f) s += zf[tt * 36 + f] * a.in[F.z + I_HYW1][((size_t)i * 33 + f) * 64 + j];
                h1[idx] = sinf(a.in[F.z + I_HYF1][i * 64 + j] * s); }
            __syncthreads();
            for (int idx = F.tid; idx < 32 * 64; idx += 512) { const int tt = idx >> 6, j = idx & 63; float s = a.in[F.z + I_HYB2][i * 64 + j];
                for (int k = 0; k < 64; ++k) s += h1[tt * 64 + k] * a.in[F.z + I_HYW2][((size_t)i * 64 + k) * 64 + j];
                h2[idx] = sinf(a.in[F.z + I_HYF2][i * 64 + j] * s); }
            __syncthreads();
            {
                const int c = F.tid;
                const float mind = logf(1e-2f) / 1.5f, maxd = logf(1e-2f) / 0.3f;
                const float delta = fabsf(mind + (float)c * ((maxd - mind) / 511.0f));
                float f0 = 0.f;
                for (int hf = 0; hf < 2; ++hf) {
                    float w3[64];
#pragma unroll
                    for (int k = 0; k < 64; ++k) w3[k] = a.in[F.z + I_HYW3][((size_t)i * 64 + k) * 1024 + hf * 512 + c];
                    for (int tt = 0; tt < 32; ++tt) {
                        const int t = t0 + tt; float s = 0.f;
#pragma unroll
                        for (int k = 0; k < 64; k += 4) { const f32x4 hv = *(const LAS f32x4*)(h2 + tt * 64 + k); s += hv[0] * w3[k] + hv[1] * w3[k + 1] + hv[2] * w3[k + 2] + hv[3] * w3[k + 3]; }
                        const float tl = (float)t / (float)(L - 1);
                        s *= expf(-tl * delta);
                        bf16_t* kr = (bf16_t*)(ws + WS_KR) + (size_t)i * (9 * MiB / 4) + (sel ? (size_t)(4 * MiB / 2) : 0) + (size_t)c * (sel ? 512 : 4096);
                        if (hf == 0) { if (t == 0) f0 = s; else kr[L - 1 - t] = (bf16_t)f2bf(s); }
                        else { if (t == 0) kr[L - 1] = (bf16_t)f2bf(f0 + s); else kr[L - 1 + t] = (bf16_t)f2bf(s); }
                    }
                }
            }
            __syncthreads();
        }
    }
}

__device__ __forceinline__ void phase_expconv(const Args& a, Frame& F, int l) {
    LAS float* scr = (LAS float*)(F.lds + F.wave * 16384);
    const int gw = F.bid * 8 + F.wave, NGW = F.G * 8;
    unsigned char* W13 = F.ws + WS_EXP; unsigned char* W2T = F.ws + WS_W2T;
    constexpr int PER_E = 3 * 256; constexpr int NIT = NEXP * PER_E;
    const float* w1b = a.in[F.z + I_EXW1] + (size_t)l * NEXP * D * DE; const float* w3b = a.in[F.z + I_EXW3] + (size_t)l * NEXP * D * DE; const float* w2b = a.in[F.z + I_EXW2] + (size_t)l * NEXP * DE * D;
    auto decode = [&](int it, const float*& src, int& ldw, unsigned char*& dst, int& ldd, float& sc) {
        const int e = it / PER_E; int r = it % PER_E;
        if (r < 512) { const int which = r >> 8; r &= 255; const int kb = r >> 4, nb = r & 15;
            const int n0 = nb * 32; const int drow = (n0 >> 7) * 256 + which * 128 + (n0 & 127);
            src = (which ? w3b : w1b) + (size_t)e * D * DE + (size_t)(kb * 64) * DE + n0; ldw = DE; dst = W13 + ((size_t)e * 1024 + drow) * 1024 + kb * 64; ldd = 1024; sc = SC_W13;
        } else { r -= 512; const int kb = r >> 5, nb = r & 31;
            src = w2b + (size_t)e * DE * D + (size_t)(kb * 64) * D + nb * 32; ldw = D; dst = W2T + (size_t)e * D * DE + (size_t)(nb * 32) * DE + kb * 64; ldd = DE; sc = SC_W2; }
    };
    unsigned* qctr = (unsigned*)(F.ws + WS_CTL) + CW_XQ + 64 * l;
    (void)gw; (void)NGW;
    for (;;) {
        int base = 0;
        if (F.lane == 0) base = (int)__hip_atomic_fetch_add(qctr, 16u, __ATOMIC_RELAXED, __HIP_MEMORY_SCOPE_AGENT);
        base = __builtin_amdgcn_readfirstlane(base);
        if (base >= NIT) break;
        const int lim = (base + 16 < NIT) ? base + 16 : NIT;
        int it = base;
        const float* src; int ldw; unsigned char* dst; int ldd; float sc;
        decode(it, src, ldw, dst, ldd, sc);
        float r0[32], r1[32];
        tile_load(r0, src, ldw, F.lane);
        for (;;) {
            const int it1 = it + 1; const bool h1 = it1 < lim; unsigned char* dst1 = dst; int ldd1 = ldd; float sc1 = sc;
            if (h1) { const float* s1; int lw1; decode(it1, s1, lw1, dst1, ldd1, sc1); tile_load(r1, s1, lw1, F.lane); }
            tile_store8(r0, dst, ldd, sc, scr, F.lane);
            if (!h1) break;
            const int it2 = it1 + 1; const bool h2 = it2 < lim;
            if (h2) { const float* s2; int lw2; decode(it2, s2, lw2, dst, ldd, sc); tile_load(r0, s2, lw2, F.lane); }
            tile_store8(r1, dst1, ldd1, sc1, scr, F.lane);
            if (!h2) break;
            it = it2;
        }
    }
}

__device__ __forceinline__ void build_tiles(Frame& F, const unsigned* cntg, bool table) {
    __syncthreads();
    if (F.tid < 64) {
        const int e = F.tid;
        const unsigned c = e < NEXP ? __hip_atomic_load(cntg + e, __ATOMIC_RELAXED, __HIP_MEMORY_SCOPE_AGENT) : 0u;
        const unsigned nt = (c + 255u) >> 8;
        int inc = (int)nt;
        inc += __builtin_amdgcn_update_dpp(0, inc, 0x111, 0xf, 0xf, false);
        inc += __builtin_amdgcn_update_dpp(0, inc, 0x112, 0xf, 0xf, false);
        inc += __builtin_amdgcn_update_dpp(0, inc, 0x114, 0xf, 0xf, false);
        inc += __builtin_amdgcn_update_dpp(0, inc, 0x118, 0xf, 0xf, false);
        inc += __builtin_amdgcn_update_dpp(0, inc, 0x142, 0xa, 0xf, false);
        inc += __builtin_amdgcn_update_dpp(0, inc, 0x143, 0xc, 0xf, false);
        const unsigned t1 = (unsigned)inc, t0 = t1 - nt;
        if (e < NEXP) { F.MISC[MW_CNT + e] = c; F.MISC[MW_TSTART + e] = t0; }
        if (e == NEXP - 1) F.MISC[MW_TSTART + NEXP] = t1;
        if (table && e < NEXP) for (unsigned t = t0; t < t1; ++t) F.MISC[MW_TILE + t] = (unsigned)e;
    }
    __syncthreads();
}

__device__ __forceinline__ void phase_norm1(const Args& a, Frame& F, int l) {
    unsigned char* ws = F.ws;
    const bool comb = l > 0, fin = (l == DEPTH);
    const float* MOD = (const float*)(ws + WS_MOD);
    if (comb) build_tiles(F, (const unsigned*)(ws + WS_CTL) + CW_CNT + (l - 1) * 32, false);
    const int rlo = (l >= 3) ? RC : 0;
    const int nrows = RT - rlo; const int NGW = F.G * 8, gw = F.bid * 8 + F.wave;
    const int per = (nrows + NGW - 1) / NGW; const int r0 = rlo + gw * per; const int r1 = (r0 + per < RT) ? r0 + per : RT;
    const u32x4* REC = (const u32x4*)(ws + WS_REC); const unsigned char* Y = ws + WS_Y;
    bf16_t* ACT = (bf16_t*)(ws + WS_ACT); bf16_t* H16 = (bf16_t*)(ws + WS_H16);
    const float* gvec = fin ? a.in[F.z + I_NFIN] : a.in[F.z + I_NMIX] + l * D;
    int curb = -1; f32x4 cA[4], cB[4], cG[4];
    u32x4 prec[2]; u32x2 ph[2][4]; f32x4 pf[2][4];
    auto request = [&](const int rw0, const int rw1) __attribute__((always_inline)) {
        if (comb) { prec[0] = REC[rw0]; prec[1] = REC[rw1]; }
        if (l > 0) { const u32x2* h0 = (const u32x2*)(H16 + (size_t)rw0 * D); const u32x2* h1 = (const u32x2*)(H16 + (size_t)rw1 * D);
#pragma unroll
            for (int j = 0; j < 4; ++j) { ph[0][j] = h0[F.lane + 64 * j]; ph[1][j] = h1[F.lane + 64 * j]; } }
        else {
            const float* s0 = rw0 < RC ? a.in[F.z + I_CTX] + (size_t)rw0 * D : a.in[F.z + I_X] + (size_t)(rw0 - RC) * D;
            const float* s1 = rw1 < RC ? a.in[F.z + I_CTX] + (size_t)rw1 * D : a.in[F.z + I_X] + (size_t)(rw1 - RC) * D;
#pragma unroll
            for (int j = 0; j < 4; ++j) { pf[0][j] = *((const f32x4*)s0 + F.lane + 64 * j); pf[1][j] = *((const f32x4*)s1 + F.lane + 64 * j); } }
    };
    { const int q0 = r0 < RT ? r0 : RT - 1, q1 = r0 + 1 < RT ? r0 + 1 : RT - 1; request(q0, q1); }
    for (int row = r0; row < r1;) {
        const int b = row < RC ? NB : ((row - RC) >> 11);
        if (b != curb) { curb = b;
#pragma unroll
            for (int j = 0; j < 4; ++j) { const int col = (F.lane + 64 * j) * 4; const f32x4 g = *(const f32x4*)(gvec + col);
                if (!fin) { const float* m = MOD + ((size_t)l * 33 + b) * 6144; const f32x4 sh = *(const f32x4*)(m + col), scv = *(const f32x4*)(m + D + col); cA[j] = g * (scv + 1.0f); cB[j] = sh; }
                else { cA[j] = g; cB[j] = (f32x4){0.f, 0.f, 0.f, 0.f}; }
                if (comb) cG[j] = *(const f32x4*)(MOD + ((size_t)(l - 1) * 33 + b) * 6144 + 5 * D + col); else cG[j] = (f32x4){0.f, 0.f, 0.f, 0.f}; }
        }
        const int rowB = row + 1; const bool two = rowB < r1 && (rowB < RC ? NB : ((rowB - RC) >> 11)) == b;
        const int rws[2] = {row, two ? rowB : row};
        f32x4 v[2][4];
        u32x4 rec[2];
        asm volatile("" : "+v"(prec[0]), "+v"(prec[1]));
#pragma unroll
        for (int j = 0; j < 4; ++j) asm volatile("" : "+v"(ph[0][j]), "+v"(ph[1][j]));
        if (comb) { rec[0] = prec[0]; rec[1] = two ? prec[1] : prec[0]; }
#pragma unroll
        for (int rr = 0; rr < 2; ++rr) {
            if (l == 0) {
#pragma unroll
                for (int j = 0; j < 4; ++j) { asm volatile("" : "+v"(pf[0][j]), "+v"(pf[1][j])); v[rr][j] = (rr == 1 && two) ? pf[1][j] : pf[0][j]; }
            } else {
#pragma unroll
                for (int j = 0; j < 4; ++j) { const u32x2 w = (rr == 1 && two) ? ph[1][j] : ph[0][j]; v[rr][j] = (f32x4){bflo(w.x), bfhi(w.x), bflo(w.y), bfhi(w.y)}; }
            }
        }
        { const int nrow = row + (two ? 2 : 1); const int q0 = nrow < RT ? nrow : RT - 1, q1 = nrow + 1 < RT ? nrow + 1 : RT - 1; request(q0, q1); }
        if (comb) {
            unsigned ya[2][4], yb[2][4]; float g0[2], g1[2];
#pragma unroll
            for (int rr = 0; rr < 2; ++rr) {
                const unsigned rx = rec[rr].x, ry = rec[rr].y, gz_ = rec[rr].z, gw_ = rec[rr].w;
                const int e0 = rx >> 20, p0 = rx & 0xfffff, e1 = ry >> 20, p1 = ry & 0xfffff;
                g0[rr] = __builtin_bit_cast(float, gz_) * (1.0f / SC_Y); g1[rr] = __builtin_bit_cast(float, gw_) * (1.0f / SC_Y);
                const size_t s0 = (size_t)F.MISC[MW_TSTART + e0] * 256 + p0, s1 = (size_t)F.MISC[MW_TSTART + e1] * 256 + p1;
                const unsigned* y0 = (const unsigned*)(Y + s0 * D); const unsigned* y1 = (const unsigned*)(Y + s1 * D);
#pragma unroll
                for (int j = 0; j < 4; ++j) { ya[rr][j] = y0[F.lane + 64 * j]; yb[rr][j] = y1[F.lane + 64 * j]; }
            }
#pragma unroll
            for (int rr = 0; rr < 2; ++rr) {
#pragma unroll
                for (int j = 0; j < 4; ++j) { const f32x4 f = up4_fp8(ya[rr][j]) * g0[rr] + up4_fp8(yb[rr][j]) * g1[rr];
                    v[rr][j] = v[rr][j] + cG[j] * f; }
                if (!fin && (rr == 0 || two)) { u32x2* hw = (u32x2*)(H16 + (size_t)rws[rr] * D);
#pragma unroll
                    for (int j = 0; j < 4; ++j) { u32x2 w; w.x = pk2(v[rr][j][0], v[rr][j][1]); w.y = pk2(v[rr][j][2], v[rr][j][3]); hw[F.lane + 64 * j] = w; }
                }
            }
        }
#pragma unroll
        for (int rr = 0; rr < 2; ++rr) {
            float ss = 0.f;
#pragma unroll
            for (int j = 0; j < 4; ++j) ss += (v[rr][j][0] * v[rr][j][0] + v[rr][j][1] * v[rr][j][1]) + (v[rr][j][2] * v[rr][j][2] + v[rr][j][3] * v[rr][j][3]);
            const float rstd = __builtin_amdgcn_rsqf(wave_sum(ss) * (1.0f / D) + EPS);
            if (rr == 0 || two) {
                if (fin) { float* orow = a.out + (size_t)(rws[rr] - RC) * D;
#pragma unroll
                    for (int j = 0; j < 4; ++j) *((f32x4*)orow + F.lane + 64 * j) = v[rr][j] * rstd * cA[j];
                } else {
                    u32x2* o = (u32x2*)(ACT + (size_t)rws[rr] * D);
#pragma unroll
                    for (int j = 0; j < 4; ++j) { const f32x4 u = v[rr][j] * rstd * cA[j] + cB[j]; u32x2 w; w.x = pk2(u[0], u[1]); w.y = pk2(u[2], u[3]); o[F.lane + 64 * j] = w; }
                }
            }
        }
        row += two ? 2 : 1;
    }
}

__device__ __forceinline__ void phase_norm2(const Args& a, Frame& F, int l) {
    unsigned char* ws = F.ws;
    const float* MOD = (const float*)(ws + WS_MOD);
    constexpr int TP = 1032;
    LAS bf16_t* tile = (LAS bf16_t*)F.lds;
    LAS float* part = (LAS float*)(F.lds + 66560);
    LAS float* lgt = (LAS float*)(F.lds + 66560 + 49152);
    LAS unsigned* recs = (LAS unsigned*)(F.lds + 66560 + 49152 + 6144);
    constexpr int NREC = 512;
    volatile LAS unsigned* hist = F.MISC + MW_HIST;
    unsigned* cntg = (unsigned*)(ws + WS_CTL) + CW_CNT + l * 32;
    const int rlo = (l >= 3) ? RC : 0; const int ngroups = (RT - rlo) / 32;
    const int per = (ngroups + F.G - 1) / F.G; const int g0 = F.bid * per; const int g1 = (g0 + per < ngroups) ? g0 + per : ngroups;
    unsigned char* ACT8 = ws + WS_ACT; const bf16_t* H16 = (const bf16_t*)(ws + WS_H16);
    const bf16_t* RW = (const bf16_t*)(ws + WS_RW) + (size_t)l * 48 * D;
    int* TOK = (int*)(ws + WS_TOK); u32x4* REC = (u32x4*)(ws + WS_REC);
    bf16x8 Bf[4][3];
    { const int n = F.lane & 15, kq = F.lane >> 4;
#pragma unroll
      for (int ks = 0; ks < 4; ++ks)
#pragma unroll
          for (int nb = 0; nb < 3; ++nb) Bf[ks][nb] = *(const bf16x8*)(RW + (size_t)(nb * 16 + n) * D + F.wave * 128 + ks * 32 + kq * 8); }
    if (F.tid < 64) hist[F.tid] = 0u;
    LAS float* rbias = (LAS float*)(F.lds + 66560 + 49152 + 6144 + NREC * 16);
    if (F.tid < 4) rbias[F.tid] = a.in[F.z + I_RTBG][l * 4 + F.tid]; else if (F.tid < 36) rbias[F.tid] = a.in[F.z + I_RTBE][l * 32 + F.tid - 4];
    int nrec = 0; int curb = -1; f32x4 cA[4], cB[4];
    __syncthreads();
    auto flush = [&]() {
        __syncthreads();
        if (F.tid < NEXP) { const unsigned h = hist[F.tid]; hist[32 + F.tid] = h ? __hip_atomic_fetch_add(cntg + F.tid, h, __ATOMIC_RELAXED, __HIP_MEMORY_SCOPE_AGENT) : 0u; hist[F.tid] = 0u; }
        __syncthreads();
        if (F.tid < nrec) {
            const unsigned tok = recs[F.tid * 4], ee = recs[F.tid * 4 + 1]; const unsigned e0 = ee & 255u, e1 = ee >> 8;
            const unsigned p0 = hist[32 + e0] + __hip_atomic_fetch_add((LAS unsigned*)&hist[e0], 1u, __ATOMIC_RELAXED, __HIP_MEMORY_SCOPE_WORKGROUP);
            const unsigned p1 = hist[32 + e1] + __hip_atomic_fetch_add((LAS unsigned*)&hist[e1], 1u, __ATOMIC_RELAXED, __HIP_MEMORY_SCOPE_WORKGROUP);
            TOK[(size_t)e0 * RT + p0] = (int)tok; TOK[(size_t)e1 * RT + p1] = (int)tok;
            u32x4 r; r.x = (e0 << 20) | p0; r.y = (e1 << 20) | p1; r.z = recs[F.tid * 4 + 2]; r.w = recs[F.tid * 4 + 3]; REC[tok] = r;
        }
        __syncthreads();
        if (F.tid < NEXP) hist[F.tid] = 0u;
        nrec = 0;
        __syncthreads();
    };
    u32x2 raw[4][4];
    if (g0 < g1) {
#pragma unroll
        for (int q = 0; q < 4; ++q) { const u32x2* hr = (const u32x2*)(H16 + (size_t)(rlo + g0 * 32 + F.wave * 4 + q) * D);
#pragma unroll
            for (int j = 0; j < 4; ++j) raw[q][j] = hr[F.lane + 64 * j]; }
    }
    for (int g = g0; g < g1; ++g) {
        const int rowg = rlo + g * 32; const int b = rowg < RC ? NB : ((rowg - RC) >> 11);
        if (b != curb) { curb = b; const float* m = MOD + ((size_t)l * 33 + b) * 6144;
#pragma unroll
            for (int j = 0; j < 4; ++j) { const int col = (F.lane + 64 * j) * 4; const f32x4 g = *(const f32x4*)(a.in[F.z + I_NFFN] + l * D + col);
                cA[j] = g * (*(const f32x4*)(m + 4 * D + col) + 1.0f); cB[j] = *(const f32x4*)(m + 3 * D + col); } }
        f32x4 v[4][4];
#pragma unroll
        for (int q = 0; q < 4; ++q)
#pragma unroll
            for (int j = 0; j < 4; ++j) { const u32x2 w = raw[q][j]; v[q][j] = (f32x4){bflo(w.x), bfhi(w.x), bflo(w.y), bfhi(w.y)}; }
        if (g + 1 < g1) {
#pragma unroll
            for (int q = 0; q < 4; ++q) { const u32x2* hr = (const u32x2*)(H16 + (size_t)(rowg + 32 + F.wave * 4 + q) * D);
#pragma unroll
                for (int j = 0; j < 4; ++j) raw[q][j] = hr[F.lane + 64 * j]; }
        }
#pragma unroll
        for (int q = 0; q < 4; ++q) { const int rl = F.wave * 4 + q; const int row = rowg + rl; float ss = 0.f;
#pragma unroll
            for (int j = 0; j < 4; ++j) ss += (v[q][j][0] * v[q][j][0] + v[q][j][1] * v[q][j][1]) + (v[q][j][2] * v[q][j][2] + v[q][j][3] * v[q][j][3]);
            const float rstd = __builtin_amdgcn_rsqf(wave_sum(ss) * (1.0f / D) + EPS);
            unsigned* o8 = (unsigned*)(ACT8 + (size_t)row * D);
#pragma unroll
            for (int j = 0; j < 4; ++j) { const f32x4 u = v[q][j] * rstd * cA[j] + cB[j]; u32x2 w; w.x = pk2(u[0], u[1]); w.y = pk2(u[2], u[3]);
                o8[F.lane + 64 * j] = pk4_fp8(u[0] * SC_V, u[1] * SC_V, u[2] * SC_V, u[3] * SC_V);
                *(LAS u32x2*)(tile + rl * TP + (F.lane + 64 * j) * 4) = w; } }
        __syncthreads();
        {
            const int rr = F.lane & 15, kq = F.lane >> 4;
#pragma unroll
            for (int rg = 0; rg < 2; ++rg) {
                f32x4 c3[3] = {(f32x4){0.f, 0.f, 0.f, 0.f}, (f32x4){0.f, 0.f, 0.f, 0.f}, (f32x4){0.f, 0.f, 0.f, 0.f}};
#pragma unroll
                for (int ks = 0; ks < 4; ++ks) { const bf16x8 af = *(const LAS bf16x8*)(tile + (rg * 16 + rr) * TP + F.wave * 128 + ks * 32 + kq * 8);
#pragma unroll
                    for (int nb = 0; nb < 3; ++nb) c3[nb] = __builtin_amdgcn_mfma_f32_16x16x32_bf16(af, Bf[ks][nb], c3[nb], 0, 0, 0); }
#pragma unroll
                for (int nb = 0; nb < 3; ++nb)
#pragma unroll
                    for (int j = 0; j < 4; ++j) part[(F.wave * 32 + rg * 16 + kq * 4 + j) * 48 + nb * 16 + rr] = c3[nb][j];
            }
        }
        __syncthreads();
        for (int idx = F.tid; idx < 32 * 48; idx += 512) { float s = 0.f;
#pragma unroll
            for (int w = 0; w < 8; ++w) s += part[w * 32 * 48 + idx];
            lgt[idx] = s; }
        __syncthreads();
        if (F.tid < 32) {
            const int row = rowg + F.tid; const LAS float* lg = lgt + F.tid * 48;
            float gl[4]; float gm = -3.0e38f; int grp = 0;
#pragma unroll
            for (int j = 0; j < 4; ++j) { gl[j] = lg[j] + rbias[j]; if (gl[j] > gm) { gm = gl[j]; grp = j; } }
            float gs = 0.f;
#pragma unroll
            for (int j = 0; j < 4; ++j) gs += __expf(gl[j] - gm);
            const float pg = __builtin_amdgcn_rcpf(gs);
            float el[8]; float m0 = -3.0e38f, m1 = -3.0e38f; int i0 = 0, i1 = 0;
#pragma unroll
            for (int j = 0; j < 8; ++j) { el[j] = lg[4 + grp * 8 + j] + rbias[4 + grp * 8 + j]; }
#pragma unroll
            for (int j = 0; j < 8; ++j) if (el[j] > m0) { m0 = el[j]; i0 = j; }
#pragma unroll
            for (int j = 0; j < 8; ++j) if (j != i0 && el[j] > m1) { m1 = el[j]; i1 = j; }
            const float x1 = __expf(m1 - m0); const float rx = __builtin_amdgcn_rcpf(1.0f + x1); float w0 = pg * rx, w1 = pg * x1 * rx;
            const unsigned e0 = (unsigned)(grp * 8 + i0), e1 = (unsigned)(grp * 8 + i1);
            const int ri = nrec + F.tid;
            recs[ri * 4] = (unsigned)row; recs[ri * 4 + 1] = e0 | (e1 << 8); recs[ri * 4 + 2] = __builtin_bit_cast(unsigned, w0); recs[ri * 4 + 3] = __builtin_bit_cast(unsigned, w1);
            __hip_atomic_fetch_add((LAS unsigned*)&hist[e0], 1u, __ATOMIC_RELAXED, __HIP_MEMORY_SCOPE_WORKGROUP); __hip_atomic_fetch_add((LAS unsigned*)&hist[e1], 1u, __ATOMIC_RELAXED, __HIP_MEMORY_SCOPE_WORKGROUP);
        }
        nrec += 32;
        if (nrec == NREC) flush();
    }
    if (nrec > 0) flush();
}


__device__ __forceinline__ void phase_gla2(const Args& a, Frame& F, int i, bool cm) {
    unsigned char* ws = F.ws;
    const bf16_t* P = (const bf16_t*)(ws + WS_P); const bf16_t* Gd = (const bf16_t*)(ws + WS_G);
    constexpr int RP = 72;
    LAS bf16_t* QD = (LAS bf16_t*)F.lds;
    LAS bf16_t* KD = QD + 64 * RP;
    LAS bf16_t* KRT = KD + 64 * RP;
    LAS bf16_t* VT = KRT + 64 * RP;
    LAS float* ST = (LAS float*)(VT + 128 * RP);
    LAS float* EBL = ST + 512;
    LAS bf16_t* OS = (LAS bf16_t*)(EBL + 64);
    const int tok = F.tid >> 3, dg = F.tid & 7;
    const int dk = F.lane;
    const int dv = F.tid & 127, tg = F.tid >> 7;
    const int l15 = F.lane & 15, kq = F.lane >> 4;
    for (int item = F.bid; item < 2 * NB * 4; item += F.G) {
        const int dir = item >> 7, b = (item >> 2) & 31, h = item & 3;
        unsigned char* O = ws + (dir ? WS_OB : WS_OF);
        f32x4 S[4];
#pragma unroll
        for (int q = 0; q < 4; ++q) S[q] = (f32x4){0.f, 0.f, 0.f, 0.f};
        auto row_of = [&](int ch, int t) -> int {
            if (ch < 4) { const int p = ch * 64 + t; return b * LC + (dir ? (LC - 1 - p) : p); }
            const int j = (ch - 4) * 64 + t; return lat_row(b, dir ? (SEQ - 1 - j) : j, cm); };
        unsigned rq[8], rk[8], rg[8], rv[16];
        const unsigned voA = (unsigned)(h * 64 + dk) * 2u, voG = (unsigned)(dir * 256 + h * 64 + dk) * 2u, voV = (unsigned)(512 + h * 128 + dv) * 2u;
#define GLA_GP(p) ((const __attribute__((address_space(1))) bf16_t*)(p))
#define GLA_LOADS(rA0, dA, rB0, dB) do { \
            _Pragma("unroll") for (int q = 0; q < 8; ++q) { const size_t row = (size_t)((rA0) + q * (dA)); unsigned long long pb = (unsigned long long)P + row * (size_t)(EVN * 2), gb = (unsigned long long)Gd + row * 1024; \
                asm volatile("" : "+s"(pb), "+s"(gb)); \
                rq[q] = *GLA_GP(pb + voA); rk[q] = *GLA_GP(pb + voA + 512); rg[q] = *GLA_GP(gb + voG); } \
            _Pragma("unroll") for (int q = 0; q < 16; ++q) { unsigned long long pb = (unsigned long long)P + (size_t)((rB0) + q * (dB)) * (size_t)(EVN * 2); asm volatile("" : "+s"(pb)); rv[q] = *GLA_GP(pb + voV); } } while (0)
        { const int rA0 = __builtin_amdgcn_readfirstlane(row_of(0, F.wave * 8)), dA = __builtin_amdgcn_readfirstlane(row_of(0, F.wave * 8 + 1)) - rA0;
          const int rB0 = __builtin_amdgcn_readfirstlane(row_of(0, tg * 16)), dB = __builtin_amdgcn_readfirstlane(row_of(0, tg * 16 + 1)) - rB0;
          GLA_LOADS(rA0, dA, rB0, dB); }
        __syncthreads();
        for (int ch = 0; ch < 36; ++ch) {
            float bb[8];
            { float run = 0.f;
#pragma unroll
              for (int q = 0; q < 8; ++q) { run += __builtin_bit_cast(float, rg[q] << 16); bb[q] = run; }
              ST[F.wave * 64 + dk] = run; }
            __syncthreads();
            {
                float pre = 0.f, tot = 0.f;
#pragma unroll
                for (int w = 0; w < 8; ++w) { const float sv = ST[w * 64 + dk]; tot += sv; if (w < F.wave) pre += sv; }
                const float etot = __expf(tot);
                unsigned krp[4];
#pragma unroll
                for (int q = 0; q < 8; ++q) {
                    const float bq = bb[q] + pre; const float e = __expf(bq), en = __builtin_amdgcn_rcpf(e), el = etot * en;
                    const float qv = __builtin_bit_cast(float, rq[q] << 16), kv = __builtin_bit_cast(float, rk[q] << 16);
                    QD[(F.wave * 8 + q) * RP + dk] = (bf16_t)f2bf(qv * 0.125f * e);
                    KD[(F.wave * 8 + q) * RP + dk] = (bf16_t)f2bf(kv * en);
                    const unsigned kb = f2bf(kv * el); if (q & 1) krp[q >> 1] |= kb << 16; else krp[q >> 1] = kb;
                }
                *(LAS u32x4*)(KRT + dk * RP + F.wave * 8) = (u32x4){krp[0], krp[1], krp[2], krp[3]};
                if (F.wave == 0) EBL[dk] = etot;
                u32x4 v0, v1;
                v0.x = (unsigned)rv[0] | ((unsigned)rv[1] << 16); v0.y = (unsigned)rv[2] | ((unsigned)rv[3] << 16); v0.z = (unsigned)rv[4] | ((unsigned)rv[5] << 16); v0.w = (unsigned)rv[6] | ((unsigned)rv[7] << 16);
                v1.x = (unsigned)rv[8] | ((unsigned)rv[9] << 16); v1.y = (unsigned)rv[10] | ((unsigned)rv[11] << 16); v1.z = (unsigned)rv[12] | ((unsigned)rv[13] << 16); v1.w = (unsigned)rv[14] | ((unsigned)rv[15] << 16);
                *(LAS u32x4*)(VT + dv * RP + tg * 16) = v0; *(LAS u32x4*)(VT + dv * RP + tg * 16 + 8) = v1;
            }
            if (ch + 1 < 36) {
                const int rA0 = __builtin_amdgcn_readfirstlane(row_of(ch + 1, F.wave * 8)), dA = __builtin_amdgcn_readfirstlane(row_of(ch + 1, F.wave * 8 + 1)) - rA0;
                const int rB0 = __builtin_amdgcn_readfirstlane(row_of(ch + 1, tg * 16)), dB = __builtin_amdgcn_readfirstlane(row_of(ch + 1, tg * 16 + 1)) - rB0;
                GLA_LOADS(rA0, dA, rB0, dB);
            }
            __syncthreads();
            {
                f32x4 C[4][4];
                {
                    bf16x8 kdf[4][2], qdf[4][2];
#pragma unroll
                    for (int sb = 0; sb < 4; ++sb)
#pragma unroll
                        for (int ks = 0; ks < 2; ++ks) { kdf[sb][ks] = *(const LAS bf16x8*)(KD + (16 * sb + l15) * RP + 32 * ks + 8 * kq); qdf[sb][ks] = *(const LAS bf16x8*)(QD + (16 * sb + l15) * RP + 32 * ks + 8 * kq); }
#pragma unroll
                    for (int sb = 0; sb < 4; ++sb)
#pragma unroll
                        for (int tb = 0; tb < 4; ++tb) {
                            f32x4 c = (f32x4){0.f, 0.f, 0.f, 0.f};
                            if (tb >= sb) {
#pragma unroll
                                for (int ks = 0; ks < 2; ++ks) c = __builtin_amdgcn_mfma_f32_16x16x32_bf16(kdf[sb][ks], qdf[tb][ks], c, 0, 0, 0);
                                if (tb == sb) {
#pragma unroll
                                    for (int rg = 0; rg < 4; ++rg) if (4 * kq + rg > l15) c[rg] = 0.f; }
                            }
                            C[sb][tb] = c;
                        }
                }
                bf16x8 sf[2];
#pragma unroll
                for (int m = 0; m < 2; ++m) { u32x4 w; w.x = pg8::cvt_pk_bf16(S[2 * m][0], S[2 * m][1]); w.y = pg8::cvt_pk_bf16(S[2 * m][2], S[2 * m][3]);
                    w.z = pg8::cvt_pk_bf16(S[2 * m + 1][0], S[2 * m + 1][1]); w.w = pg8::cvt_pk_bf16(S[2 * m + 1][2], S[2 * m + 1][3]); sf[m] = __builtin_bit_cast(bf16x8, w); }
                bf16x8 vtp[2];
#pragma unroll
                for (int m = 0; m < 2; ++m) { const u32x2 lo = *(const LAS u32x2*)(VT + (16 * F.wave + l15) * RP + 32 * m + 4 * kq), hi = *(const LAS u32x2*)(VT + (16 * F.wave + l15) * RP + 32 * m + 16 + 4 * kq);
                    vtp[m] = __builtin_bit_cast(bf16x8, (u32x4){lo.x, lo.y, hi.x, hi.y}); }
#pragma unroll
                for (int tb = 0; tb < 4; ++tb) {
                    f32x4 o = (f32x4){0.f, 0.f, 0.f, 0.f};
#pragma unroll
                    for (int m = 0; m < 2; ++m) if (2 * m <= tb) {
                        const f32x4 lo = C[2 * m][tb], hi = C[2 * m + 1][tb];
                        u32x4 w; w.x = pg8::cvt_pk_bf16(lo[0], lo[1]); w.y = pg8::cvt_pk_bf16(lo[2], lo[3]); w.z = pg8::cvt_pk_bf16(hi[0], hi[1]); w.w = pg8::cvt_pk_bf16(hi[2], hi[3]);
                        o = __builtin_amdgcn_mfma_f32_16x16x32_bf16(vtp[m], __builtin_bit_cast(bf16x8, w), o, 0, 0, 0); }
#pragma unroll
                    for (int m = 0; m < 2; ++m) { const u32x2 lo = *(const LAS u32x2*)(QD + (16 * tb + l15) * RP + 32 * m + 4 * kq), hi = *(const LAS u32x2*)(QD + (16 * tb + l15) * RP + 32 * m + 16 + 4 * kq);
                        o = __builtin_amdgcn_mfma_f32_16x16x32_bf16(sf[m], __builtin_bit_cast(bf16x8, (u32x4){lo.x, lo.y, hi.x, hi.y}), o, 0, 0, 0); }
                    { u32x2 ow; ow.x = pg8::cvt_pk_bf16(o[0], o[1]); ow.y = pg8::cvt_pk_bf16(o[2], o[3]); *(LAS u32x2*)(OS + (16 * tb + l15) * 136 + 16 * F.wave + 4 * kq) = ow; }
                }
#pragma unroll
                for (int q = 0; q < 4; ++q) { const f32x4 sc = *(const LAS f32x4*)(EBL + 16 * q + 4 * kq); S[q] = S[q] * sc; }
#pragma unroll
                for (int m = 0; m < 2; ++m) { const bf16x8 vn = *(const LAS bf16x8*)(VT + (16 * F.wave + l15) * RP + 32 * m + 8 * kq);
#pragma unroll
                    for (int q = 0; q < 4; ++q) S[q] = __builtin_amdgcn_mfma_f32_16x16x32_bf16(*(const LAS bf16x8*)(KRT + (16 * q + l15) * RP + 32 * m + 8 * kq), vn, S[q], 0, 0, 0); }
            }
            __syncthreads();
            {
                unsigned char* op = O + (size_t)row_of(ch, tok) * 512 + h * 128 + dg * 16;
                const u32x4 w0 = *(const LAS u32x4*)(OS + tok * 136 + dg * 16), w1 = *(const LAS u32x4*)(OS + tok * 136 + dg * 16 + 8);
                u32x4 o8;
                o8.x = pk4_fp8(bflo(w0.x) * SC_O, bfhi(w0.x) * SC_O, bflo(w0.y) * SC_O, bfhi(w0.y) * SC_O); o8.y = pk4_fp8(bflo(w0.z) * SC_O, bfhi(w0.z) * SC_O, bflo(w0.w) * SC_O, bfhi(w0.w) * SC_O);
                o8.z = pk4_fp8(bflo(w1.x) * SC_O, bfhi(w1.x) * SC_O, bflo(w1.y) * SC_O, bfhi(w1.y) * SC_O); o8.w = pk4_fp8(bflo(w1.z) * SC_O, bfhi(w1.z) * SC_O, bflo(w1.w) * SC_O, bfhi(w1.w) * SC_O);
                *(u32x4*)op = o8;
            }
#pragma unroll
            for (int q = 0; q < 8; ++q) asm volatile("" : "+v"(rq[q]), "+v"(rk[q]), "+v"(rg[q]));
#pragma unroll
            for (int q = 0; q < 16; ++q) asm volatile("" : "+v"(rv[q]));
        }
    }
    __syncthreads();
#undef GLA_LOADS
#undef GLA_GP
}


constexpr int HP_L = SEQ + 64, HP_C = LC + 64;
constexpr size_t HC_L = (size_t)NB * HP_L + 128, HC_C = (size_t)NB * HP_C + 128;
constexpr size_t HY_CTX0 = (size_t)HYW * HC_L;
static_assert((HY_CTX0 + (size_t)HYW * HC_C) * 2 <= 80 * MiB, "padded hyena layout fits its regions");
__device__ __forceinline__ size_t hy_row(bool lat, int c, int b) { return lat ? (size_t)c * HC_L + (size_t)b * HP_L : HY_CTX0 + (size_t)c * HC_C + (size_t)b * HP_C; }
__device__ __forceinline__ void phase_hypre2(const Args& a, Frame& F, int i, bool cm) {
    unsigned char* ws = F.ws;
    const bf16_t* P = (const bf16_t*)(ws + WS_P);
    bf16_t* WT = (bf16_t*)(ws + WS_WT); bf16_t* XT = (bf16_t*)(ws + WS_X0T);
    constexpr int TP = 520;
    LAS bf16_t* tw = (LAS bf16_t*)F.lds; LAS bf16_t* tx = tw + 64 * TP;
    const float* cw = a.in[F.z + I_HYCW] + (size_t)i * 3 * 1536; const float* cb = a.in[F.z + I_HYCB] + (size_t)i * 1536;
    const int c0 = F.lane * 8;
    constexpr int NU_L = NB * (SEQ / 64), NU_C = NB * (LC / 64);
    u32x4 pre[10];
    auto load_part0 = [&](const int un, u32x4 (&dst)[10]) __attribute__((always_inline)) {
        const bool lat_ = un < NU_L; const int L_ = lat_ ? SEQ : LC; const int uu_ = lat_ ? un : un - NU_L; const int tpb_ = L_ / 64, b_ = uu_ / tpb_, p0_ = (uu_ % tpb_) * 64;
#pragma unroll
        for (int q = 0; q < 10; ++q) { const int pp = p0_ + F.wave * 8 - 1 + q;
            if (pp >= 0 && pp < L_) { const int rr = lat_ ? lat_row(b_, pp, cm) : (b_ * LC + pp); dst[q] = *(const u32x4*)(P + (size_t)rr * EVN + 1536 + c0); }
            else dst[q] = (u32x4){0u, 0u, 0u, 0u}; } };
    if (F.bid < NU_L + NU_C) load_part0(F.bid, pre);
    for (int unit = F.bid; unit < NU_L + NU_C; unit += F.G) {
        const bool lat = unit < NU_L; const int L = lat ? SEQ : LC; const int uu = lat ? unit : unit - NU_L;
        const int tpb = L / 64, b = uu / tpb, p0 = (uu % tpb) * 64;
        __syncthreads();
        {
            float x1r[8][8];
#pragma unroll
            for (int part = 0; part < 3; ++part) {
                asm volatile("" ::: "memory");
                float kw[3][8], kb[8];
                { const f32x4 ba_ = *(const f32x4*)(cb + part * 512 + c0), bb_ = *(const f32x4*)(cb + part * 512 + c0 + 4);
#pragma unroll
                  for (int j = 0; j < 4; ++j) { kb[j] = ba_[j]; kb[4 + j] = bb_[j]; } }
#pragma unroll
                for (int k = 0; k < 3; ++k) { const f32x4 wa_ = *(const f32x4*)(cw + k * 1536 + part * 512 + c0), wb_ = *(const f32x4*)(cw + k * 1536 + part * 512 + c0 + 4);
#pragma unroll
                    for (int j = 0; j < 4; ++j) { kw[k][j] = wa_[j]; kw[k][4 + j] = wb_[j]; } }
                u32x4 rr_[10];
                if (part == 0) {
#pragma unroll
                    for (int q = 0; q < 10; ++q) { asm volatile("" : "+v"(pre[q])); rr_[q] = pre[q]; }
                } else {
#pragma unroll
                    for (int q = 0; q < 10; ++q) { const int pp = p0 + F.wave * 8 - 1 + q;
                        if (pp >= 0 && pp < L) { const int rr = lat ? lat_row(b, pp, cm) : (b * LC + pp); rr_[q] = *(const u32x4*)(P + (size_t)rr * EVN + 1536 + part * 512 + c0); }
                        else rr_[q] = (u32x4){0u, 0u, 0u, 0u}; }
                }
#pragma unroll
                for (int q = 0; q < 8; ++q) {
                    const int pl = F.wave * 8 + q;
                    float y[8];
#pragma unroll
                    for (int j = 0; j < 8; ++j) y[j] = kb[j];
#pragma unroll
                    for (int k = 0; k < 3; ++k) { const unsigned zw[4] = {rr_[q + k].x, rr_[q + k].y, rr_[q + k].z, rr_[q + k].w};
#pragma unroll
                        for (int j = 0; j < 4; ++j) { y[2 * j] += kw[k][2 * j] * bflo(zw[j]); y[2 * j + 1] += kw[k][2 * j + 1] * bfhi(zw[j]); } }
                    if (part == 0) { u32x4 ox; ox.x = pk2(y[0], y[1]); ox.y = pk2(y[2], y[3]); ox.z = pk2(y[4], y[5]); ox.w = pk2(y[6], y[7]); *(LAS u32x4*)(tx + pl * TP + c0) = ox; }
                    else if (part == 1) {
#pragma unroll
                        for (int j = 0; j < 8; ++j) x1r[q][j] = y[j]; }
                    else { u32x4 ow; ow.x = pk2(y[0] * x1r[q][0], y[1] * x1r[q][1]); ow.y = pk2(y[2] * x1r[q][2], y[3] * x1r[q][3]); ow.z = pk2(y[4] * x1r[q][4], y[5] * x1r[q][5]); ow.w = pk2(y[6] * x1r[q][6], y[7] * x1r[q][7]);
                        *(LAS u32x4*)(tw + pl * TP + c0) = ow; }
                }
            }
        }
        { const int un = unit + F.G; load_part0(un < NU_L + NU_C ? un : unit, pre); }
        __syncthreads();
        {
            const int c = F.tid;
            bf16_t* wdst = WT + hy_row(lat, c, b) + p0;
            bf16_t* xdst = XT + hy_row(lat, c, b) + p0;
#pragma unroll 2
            for (int ch = 0; ch < 8; ++ch) {
                unsigned wv[4], xv[4];
#pragma unroll
                for (int k = 0; k < 4; ++k) {
                    wv[k] = (unsigned)tw[(ch * 8 + 2 * k) * TP + c] | ((unsigned)tw[(ch * 8 + 2 * k + 1) * TP + c] << 16);
                    xv[k] = (unsigned)tx[(ch * 8 + 2 * k) * TP + c] | ((unsigned)tx[(ch * 8 + 2 * k + 1) * TP + c] << 16); }
                *(u32x4*)(wdst + ch * 8) = (u32x4){wv[0], wv[1], wv[2], wv[3]};
                *(u32x4*)(xdst + ch * 8) = (u32x4){xv[0], xv[1], xv[2], xv[3]};
            }
        }
    }
    __syncthreads();
}

typedef float f32x16 __attribute__((ext_vector_type(16)));
__device__ __forceinline__ bf16x8 toep_frag(const LAS unsigned* kr32, int v0) {
    const int q0 = v0 >> 1; const unsigned sh = (unsigned)(v0 & 1) * 16u;
    const unsigned d0 = kr32[q0], d1 = kr32[q0 + 1], d2 = kr32[q0 + 2], d3 = kr32[q0 + 3], d4 = kr32[q0 + 4];
    u32x4 o; o.x = __builtin_amdgcn_alignbit(d1, d0, sh); o.y = __builtin_amdgcn_alignbit(d2, d1, sh); o.z = __builtin_amdgcn_alignbit(d3, d2, sh); o.w = __builtin_amdgcn_alignbit(d4, d3, sh);
    return __builtin_bit_cast(bf16x8, o);
}
__device__ __forceinline__ void phase_hyconv2(const Args& a, Frame& F, int i) {
    unsigned char* ws = F.ws;
    const bf16_t* WT = (const bf16_t*)(ws + WS_WT); bf16_t* XT = (bf16_t*)(ws + WS_X0T);
    LAS unsigned* krl = (LAS unsigned*)F.lds;
    const int r = F.lane & 31, h = F.lane >> 5;
    constexpr int NU_L = HYW, NU_C = HYW / 8;
    for (int unit = F.bid; unit < NU_L + NU_C; unit += F.G) {
        const bool lat = unit < NU_L; const int L = lat ? SEQ : LC;
        const int c = lat ? unit : (unit - NU_L) * 8 + F.wave; const int T = lat ? F.wave * 256 : 0;
        const bf16_t* KRg = (const bf16_t*)(ws + WS_KR) + (size_t)i * (9 * MiB / 4) + (lat ? 0 : (size_t)(4 * MiB / 2));
        __syncthreads();
        if (lat) { const u32x4* src = (const u32x4*)(KRg + (size_t)c * 4096); for (int idx = F.tid; idx < 512; idx += 512) *(LAS u32x4*)(krl + idx * 4) = src[idx]; }
        else { const u32x4* src = (const u32x4*)(KRg + (size_t)((unit - NU_L) * 8) * 512); for (int idx = F.tid; idx < 512; idx += 512) *(LAS u32x4*)(krl + idx * 4) = src[idx]; }
        __syncthreads();
        const LAS unsigned* kr32 = lat ? krl : krl + F.wave * 256;
        const bf16_t* wsrc = WT + hy_row(lat, c, r) + 8 * h;
        f32x16 acc[8];
#pragma unroll
        for (int q = 0; q < 8; ++q)
#pragma unroll
            for (int e = 0; e < 16; ++e) acc[q][e] = 0.f;
        bf16x8 win[16];
        const int vb = (L - 1) - T - r + 8 * h;
#pragma unroll
        for (int q = 1; q < 8; ++q) { win[(2 * q) & 15] = toep_frag(kr32, vb - 32 * q); win[(2 * q - 1) & 15] = toep_frag(kr32, vb - 32 * q + 16); }
        const int nso = L / 256;
        constexpr int RD = 2;
        bf16x8 bring[RD];
#pragma unroll
        for (int q = 0; q < RD; ++q) bring[q] = *(const bf16x8*)(wsrc + 16 * q);
        for (int jo = 0; jo < nso; ++jo) {
#pragma unroll
            for (int jj = 0; jj < 16; ++jj) {
                const int s0 = (jo * 16 + jj) * 16;
                const bf16x8 bcur = bring[jj & (RD - 1)];
                const int snext = (s0 + 16 * RD < L) ? s0 + 16 * RD : s0;
                bring[jj & (RD - 1)] = *(const bf16x8*)(wsrc + snext);
                const int v0 = vb + s0, q0 = v0 >> 1; const unsigned sh = (unsigned)(v0 & 1) * 16u;
                const unsigned d0 = kr32[q0], d1 = kr32[q0 + 1], d2 = kr32[q0 + 2], d3 = kr32[q0 + 3], d4 = kr32[q0 + 4];
                __builtin_amdgcn_sched_barrier(0);
#pragma unroll
                for (int q = 7; q >= 1; --q) acc[q] = __builtin_amdgcn_mfma_f32_32x32x16_bf16(win[(2 * q - jj + 16) & 15], bcur, acc[q], 0, 0, 0);
                __builtin_amdgcn_sched_barrier(0);
                { u32x4 o; o.x = __builtin_amdgcn_alignbit(d1, d0, sh); o.y = __builtin_amdgcn_alignbit(d2, d1, sh); o.z = __builtin_amdgcn_alignbit(d3, d2, sh); o.w = __builtin_amdgcn_alignbit(d4, d3, sh);
                  win[(16 - jj) & 15] = __builtin_bit_cast(bf16x8, o); }
                acc[0] = __builtin_amdgcn_mfma_f32_32x32x16_bf16(win[(16 - jj) & 15], bcur, acc[0], 0, 0, 0);
            }
        }
        const float skip = a.in[F.z + I_HYSKIP][i * HYW + c];
        if (lat) {
            __syncthreads();
            LAS unsigned char* ep = F.lds + F.wave * 16896;
#pragma unroll
            for (int q = 0; q < 8; ++q)
#pragma unroll
                for (int g = 0; g < 4; ++g) { u32x2 yv; yv.x = pk2(acc[q][4 * g + 0], acc[q][4 * g + 1]); yv.y = pk2(acc[q][4 * g + 2], acc[q][4 * g + 3]);
                    *(LAS u32x2*)(ep + r * 528 + (32 * q + 8 * g + 4 * h) * 2) = yv; }
            LDS_WAIT(); asm volatile("" ::: "memory");
#pragma unroll 1
            for (int hb = 0; hb < 4; ++hb) {
                u32x4 wv8[4], xv8[4];
#pragma unroll
                for (int j = 0; j < 4; ++j) { const int ch = (hb * 4 + j) * 64 + F.lane; const int row = ch >> 5, tc = ch & 31; const size_t off = hy_row(true, c, row) + T + tc * 8;
                    wv8[j] = *(const u32x4*)(WT + off); xv8[j] = *(const u32x4*)(XT + off); }
                __builtin_amdgcn_sched_barrier(0);
#pragma unroll
                for (int j = 0; j < 4; ++j) { const int ch = (hb * 4 + j) * 64 + F.lane; const int row = ch >> 5, tc = ch & 31; const size_t off = hy_row(true, c, row) + T + tc * 8;
                    const u32x4 yv = *(const LAS u32x4*)(ep + row * 528 + tc * 16);
                    const unsigned yw[4] = {yv.x, yv.y, yv.z, yv.w}, ww[4] = {wv8[j].x, wv8[j].y, wv8[j].z, wv8[j].w}, xw[4] = {xv8[j].x, xv8[j].y, xv8[j].z, xv8[j].w};
                    unsigned ow[4];
#pragma unroll
                    for (int e = 0; e < 4; ++e) ow[e] = pk2(bflo(xw[e]) * (bflo(yw[e]) + skip * bflo(ww[e])), bfhi(xw[e]) * (bfhi(yw[e]) + skip * bfhi(ww[e])));
                    *(u32x4*)(XT + off) = (u32x4){ow[0], ow[1], ow[2], ow[3]}; }
                __builtin_amdgcn_sched_barrier(0);
            }
        } else {
            const size_t rowoff = hy_row(false, c, r);
#pragma unroll
            for (int q = 0; q < 8; ++q)
#pragma unroll
                for (int g = 0; g < 4; ++g) {
                    const int t = T + 32 * q + 8 * g + 4 * h;
                    const u32x2 wv = *(const u32x2*)(WT + rowoff + t); const u32x2 xv = *(const u32x2*)(XT + rowoff + t);
                    const float o0 = bflo(xv.x) * (acc[q][4 * g + 0] + skip * bflo(wv.x)), o1 = bfhi(xv.x) * (acc[q][4 * g + 1] + skip * bfhi(wv.x));
                    const float o2 = bflo(xv.y) * (acc[q][4 * g + 2] + skip * bflo(wv.y)), o3 = bfhi(xv.y) * (acc[q][4 * g + 3] + skip * bfhi(wv.y));
                    u32x2 ov; ov.x = pk2(o0, o1); ov.y = pk2(o2, o3);
                    *(u32x2*)(XT + rowoff + t) = ov;
                }
        }
    }
    __syncthreads();
}
__device__ __forceinline__ void phase_hyfin(const Args& a, Frame& F, bool cm) {
    unsigned char* ws = F.ws;
    const bf16_t* XT = (const bf16_t*)(ws + WS_X0T); bf16_t* ACT = (bf16_t*)(ws + WS_ACT);
    constexpr int TP = 520;
    LAS bf16_t* tl = (LAS bf16_t*)F.lds;
    constexpr int NU_L = NB * (SEQ / 64), NU_C = NB * (LC / 64);
    u32x4 pv[8];
    auto request = [&](const int un) __attribute__((always_inline)) {
        const bool lat_ = un < NU_L; const int L_ = lat_ ? SEQ : LC; const int uu_ = lat_ ? un : un - NU_L; const int tpb_ = L_ / 64, b_ = uu_ / tpb_, p0_ = (uu_ % tpb_) * 64;
        const bf16_t* src = XT + hy_row(lat_, F.tid, b_) + p0_;
#pragma unroll
        for (int ch = 0; ch < 8; ++ch) pv[ch] = *(const u32x4*)(src + ch * 8); };
    if (F.bid < NU_L + NU_C) request(F.bid);
    for (int unit = F.bid; unit < NU_L + NU_C; unit += F.G) {
        const bool lat = unit < NU_L; const int L = lat ? SEQ : LC; const int uu = lat ? unit : unit - NU_L;
        const int tpb = L / 64, b = uu / tpb, p0 = (uu % tpb) * 64;
        __syncthreads();
        {
            const int c = F.tid;
#pragma unroll
            for (int ch = 0; ch < 8; ++ch) { asm volatile("" : "+v"(pv[ch])); const u32x4 v = pv[ch]; const unsigned vw[4] = {v.x, v.y, v.z, v.w};
#pragma unroll
                for (int k = 0; k < 4; ++k) { tl[(ch * 8 + 2 * k) * TP + c] = (bf16_t)(vw[k] & 0xffffu); tl[(ch * 8 + 2 * k + 1) * TP + c] = (bf16_t)(vw[k] >> 16); } }
        }
        { const int un = unit + F.G; request(un < NU_L + NU_C ? un : unit); }
        __syncthreads();
        for (int q = 0; q < 8; ++q) { const int pl = F.wave * 8 + q, pos = p0 + pl; const int row = lat ? lat_row(b, pos, cm) : (b * LC + pos);
            *(u32x4*)(ACT + (size_t)row * D + 512 + F.lane * 8) = *(const LAS u32x4*)(tl + pl * TP + F.lane * 8); }
    }
    __syncthreads();
}

__device__ __forceinline__ void phase_readout(const Args& a, Frame& F, int i) {
    unsigned char* ws = F.ws;
    const bf16_t* P = (const bf16_t*)(ws + WS_P); const unsigned char* OF = ws + WS_OF; const unsigned char* OB = ws + WS_OB; bf16_t* ACT = (bf16_t*)(ws + WS_ACT);
    const int c0 = F.lane * 8; float gn[8];
#pragma unroll
    for (int j = 0; j < 8; ++j) gn[j] = a.in[F.z + I_GLAN][i * 128 + ((c0 + j) & 127)];
    const int NGW = F.G * 8;
    for (int row0 = F.bid * 8 + F.wave; row0 < RT; row0 += 4 * NGW) {
      u32x2 fa4[4], fb4[4]; u32x4 gg4[4];
#pragma unroll
      for (int jr = 0; jr < 4; ++jr) { const int rw = row0 + jr * NGW; const size_t rq = (size_t)(rw < RT ? rw : row0);
          fa4[jr] = *(const u32x2*)(OF + rq * 512 + c0); fb4[jr] = *(const u32x2*)(OB + rq * 512 + c0); gg4[jr] = *(const u32x4*)(P + rq * EVN + 1024 + c0); }
      __builtin_amdgcn_sched_barrier(0);
#pragma unroll
      for (int jr = 0; jr < 4; ++jr) { const int row = row0 + jr * NGW; if (row >= RT) break;
        const u32x2 fa = fa4[jr], fb = fb4[jr]; const u32x4 gg = gg4[jr];
        const unsigned gw[4] = {gg.x, gg.y, gg.z, gg.w};
        const f32x4 oa = up4_fp8(fa.x) + up4_fp8(fb.x), ob = up4_fp8(fa.y) + up4_fp8(fb.y);
        float o[8], g[8]; float ss = 0.f;
#pragma unroll
        for (int j = 0; j < 4; ++j) { o[j] = oa[j] * (1.0f / SC_O); o[4 + j] = ob[j] * (1.0f / SC_O); g[2 * j] = bflo(gw[j]); g[2 * j + 1] = bfhi(gw[j]); }
#pragma unroll
        for (int j = 0; j < 8; ++j) ss += o[j] * o[j];
        ss += __builtin_bit_cast(float, __builtin_amdgcn_update_dpp(0, __builtin_bit_cast(int, ss), 0x128, 0xf, 0xf, false));
        ss += __builtin_bit_cast(float, __builtin_amdgcn_update_dpp(0, __builtin_bit_cast(int, ss), 0x124, 0xf, 0xf, false));
        ss += __builtin_bit_cast(float, __builtin_amdgcn_update_dpp(0, __builtin_bit_cast(int, ss), 0x122, 0xf, 0xf, false));
        ss += __builtin_bit_cast(float, __builtin_amdgcn_update_dpp(0, __builtin_bit_cast(int, ss), 0x121, 0xf, 0xf, false));
        const float rstd = __builtin_amdgcn_rsqf(ss * (1.0f / 128.0f) + EPS);
        float r[8];
#pragma unroll
        for (int j = 0; j < 8; ++j) { r[j] = o[j] * rstd * gn[j] * silu_f(g[j]); }
        u32x4 w; w.x = pk2(r[0], r[1]); w.y = pk2(r[2], r[3]); w.z = pk2(r[4], r[5]); w.w = pk2(r[6], r[7]);
        *(u32x4*)(ACT + (size_t)row * D + c0) = w;
      }
    }
}

__device__ __forceinline__ void phase_oddmix(const Args& a, Frame& F, int i, bool cm, int rlo) {
    unsigned char* ws = F.ws;
    const bf16_t* P = (const bf16_t*)(ws + WS_P); unsigned char* ACT8 = ws + WS_ACT;
    const float* cw = a.in[F.z + I_ODCW] + (size_t)i * 3 * D;
    const int NGW = F.G * 8; const int nunits = ((RT - rlo) / 8) * 2;
    for (int unit = F.bid * 8 + F.wave; unit < nunits; unit += NGW) {
        const int hh = unit & 1, g = rlo + (unit >> 1) * 8;
        const bool lat = g >= RC; const int L = lat ? SEQ : LC; const int b = lat ? ((g - RC) >> 11) : (g >> 8); const int p0 = lat ? ((g - RC) & 2047) : (g & 255);
        const int c0 = hh * 512 + F.lane * 8;
        float w[3][8];
#pragma unroll
        for (int k = 0; k < 3; ++k) { const f32x4 wa = *(const f32x4*)(cw + k * D + c0), wb = *(const f32x4*)(cw + k * D + c0 + 4);
#pragma unroll
            for (int j = 0; j < 4; ++j) { w[k][j] = wa[j] * SC_Z; w[k][4 + j] = wb[j] * SC_Z; } }
        auto rowof = [&](int p) -> int { return lat ? lat_row(b, p, cm) : (b * LC + p); };
        u32x4 rc[10], rb[8];
#pragma unroll
        for (int q = 0; q < 10; ++q) { const int p = p0 - 1 + q;
            if (p >= 0 && p < L) { const bf16_t* pr = P + (size_t)rowof(p) * ODP; rc[q] = *(const u32x4*)(pr + 1024 + c0); if (q >= 1 && q <= 8) rb[q - 1] = *(const u32x4*)(pr + c0); }
            else rc[q] = (u32x4){0u, 0u, 0u, 0u}; }
        float pv[3][8];
#pragma unroll
        for (int q = 0; q < 10; ++q) {
            const unsigned cwv[4] = {rc[q].x, rc[q].y, rc[q].z, rc[q].w};
#pragma unroll
            for (int j = 0; j < 4; ++j) { pv[q % 3][2 * j] = bflo(cwv[j]); pv[q % 3][2 * j + 1] = bfhi(cwv[j]); }
            if (q >= 2) {
                const int qo = q - 2; const unsigned bw[4] = {rb[qo].x, rb[qo].y, rb[qo].z, rb[qo].w};
                float sacc[8];
#pragma unroll
                for (int j = 0; j < 8; ++j) sacc[j] = w[0][j] * pv[(q - 2) % 3][j] + w[1][j] * pv[(q - 1) % 3][j] + w[2][j] * pv[q % 3][j];
                u32x2 o; o.x = pk4_fp8(bflo(bw[0]) * sacc[0], bfhi(bw[0]) * sacc[1], bflo(bw[1]) * sacc[2], bfhi(bw[1]) * sacc[3]);
                o.y = pk4_fp8(bflo(bw[2]) * sacc[4], bfhi(bw[2]) * sacc[5], bflo(bw[3]) * sacc[6], bfhi(bw[3]) * sacc[7]);
                *(u32x2*)(ACT8 + (size_t)rowof(p0 + qo) * D + c0) = o;
            }
        }
    }
}

#ifndef EN_PRE
#define EN_PRE 1
#endif
#ifndef EN_NORM1
#define EN_NORM1 1
#endif
#ifndef EN_GIN
#define EN_GIN 1
#endif
#ifndef EN_GLA
#define EN_GLA 1
#endif
#ifndef EN_HYPRE
#define EN_HYPRE 1
#endif
#ifndef EN_ODD
#define EN_ODD 1
#endif
#ifndef EN_HYCONV
#define EN_HYCONV 1
#endif
#ifndef EN_READ
#define EN_READ 1
#endif
#ifndef EN_GOUT
#define EN_GOUT 1
#endif
#ifndef EN_EXPC
#define EN_EXPC 1
#endif
#ifndef EN_NORM2
#define EN_NORM2 1
#endif
#ifndef EN_MOE1
#define EN_MOE1 1
#endif
#ifndef EN_MOE2
#define EN_MOE2 1
#endif
constexpr int N_PHASES = 38, PH_FINAL = 37;
__global__ void __launch_bounds__(512, 2) fwd_kernel(Args args) {
    extern __shared__ __attribute__((aligned(16))) unsigned char lds_raw[];
    Frame F;
    F.lds = (LAS unsigned char*)lds_raw;
    F.MISC = (volatile LAS unsigned*)(F.lds + LDS_MISC);
    F.tid = threadIdx.x; F.lane = F.tid & 63; F.wave = __builtin_amdgcn_readfirstlane(F.tid >> 6);
    F.G = gridDim.x; F.bid = blockIdx.x; F.z = 0; F.ws = args.ws;
    unsigned char* ws = args.ws;
    for (int u = F.tid; u < (LDS_BYTES - LDS_MISC) / 4; u += 512) ((LAS unsigned*)(F.lds + LDS_MISC))[u] = 0u;
    __syncthreads();
    XcdBarrier bar; bar.bar = (unsigned*)(ws + WS_CTL) + CW_BAR; bar.x = 0; bar.st = nullptr;
    if (args.fused) bar = xcd_barrier_post((unsigned*)(ws + WS_CTL) + CW_BAR, F.MISC + MW_BAR);
    const int lo = args.ph_lo, hi = args.ph_hi;
#define IN(k) (lo <= (k) && (k) < hi)
#define ENTER() do { int z_; asm volatile("s_mov_b32 %0, 0" : "=s"(z_)); F.z = z_; F.tid = (int)threadIdx.x + z_; F.lane = F.tid & 63; F.wave = __builtin_amdgcn_readfirstlane(F.tid >> 6); F.bid = (int)blockIdx.x + z_; F.ws = args.ws + z_; ws = F.ws; } while (0)
#define SEAM(k) do { if (args.fused && IN((k) + 1)) { xcd_barrier(bar); } } while (0)

    if (IN(0)) { ENTER(); if (EN_PRE) phase_pre(args, F); SEAM(0); }

    for (int l = 0; l < DEPTH; ++l) {
        const int pb = 1 + 9 * l; const int i = l >> 1; const bool even = (l & 1) == 0; const bool cm = (i & 1) == 1;
        const int rlo = (l == 3) ? RC : 0;
        const int nM = (RT - rlo) / 256;
        if (IN(pb + 0)) { ENTER(); if (EN_NORM1) phase_norm1(args, F, l); SEAM(pb + 0); }
        if (IN(pb + 1)) { ENTER();
            ProbIn p; p.A = (const bf16_t*)(ws + WS_ACT); p.O = (bf16_t*)(ws + WS_P); p.K = D; p.nM = nM; p.row0 = rlo; p.G = F.G; p.c = F.bid;
            p.Gd = (bf16_t*)(ws + WS_G); p.gbf = args.in[F.z + I_BAF] + i * 256; p.gbb = args.in[F.z + I_BAB] + i * 256;
            if (even) { p.Bt = (const bf16_t*)(ws + WS_WEVIN) + (size_t)i * EVNP * D; p.nN = EVNP / 256; p.ncols = EVN; p.ldc = EVN; p.prod0 = 1 << 30; }
            else { p.Bt = (const bf16_t*)(ws + WS_WODIN) + (size_t)i * ODN * D; p.nN = ODN / 256; p.ncols = ODN; p.ldc = ODP; p.prod0 = 1024; }
            if (EN_GIN) pg8::gemm_phase<ProbIn>(F.lds, p, F.tid);
            SEAM(pb + 1);
        }
        if (IN(pb + 2)) { ENTER();
            if (even) { if (EN_GLA) phase_gla2(args, F, i, cm); if (EN_HYPRE) phase_hypre2(args, F, i, cm); }
            else if (EN_ODD) phase_oddmix(args, F, i, cm, rlo);
            SEAM(pb + 2);
        }
        if (IN(pb + 3) && even) { ENTER();
            if (EN_HYCONV) phase_hyconv2(args, F, i);
            SEAM(pb + 3);
        }
        if (IN(pb + 4) && even) { ENTER();
            phase_hyfin(args, F, cm);
            if (EN_READ) phase_readout(args, F, i);
            SEAM(pb + 4);
        }
        if (IN(pb + 5)) { ENTER();
            if (even) {
                ProbOut<false> p; p.A = ws + WS_ACT; p.K = D; p.nM = nM; p.nN = 4; p.row0 = rlo; p.G = F.G; p.c = F.bid;
                p.Bt = ws + WS_WEVOUT + (size_t)i * D * D * 2;
                p.x_c = args.in[F.z + I_CTX]; p.x_l = args.in[F.z + I_X]; p.first = (l == 0); p.H16 = (bf16_t*)(ws + WS_H16); p.gate = (const float*)(ws + WS_MOD) + (size_t)l * 33 * 6144 + 2 * D;
                if (EN_GOUT) pg8::gemm_phase<ProbOut<false>>(F.lds, p, F.tid);
            } else {
                ProbOut<true> p; p.A = ws + WS_ACT; p.K = D; p.nM = nM; p.nN = 4; p.row0 = rlo; p.G = F.G; p.c = F.bid;
                p.Bt = ws + WS_WODOUT + (size_t)i * D * D;
                p.x_c = args.in[F.z + I_CTX]; p.x_l = args.in[F.z + I_X]; p.first = 0; p.H16 = (bf16_t*)(ws + WS_H16); p.gate = (const float*)(ws + WS_MOD) + (size_t)l * 33 * 6144 + 2 * D;
                if (EN_GOUT) pg8::gemm_phase<ProbOut<true>>(F.lds, p, F.tid);
            }
            if (EN_EXPC) phase_expconv(args, F, l);
            SEAM(pb + 5);
        }
        if (IN(pb + 6)) { ENTER(); if (EN_NORM2) phase_norm2(args, F, l); SEAM(pb + 6); }
        if (IN(pb + 7)) { ENTER();
            build_tiles(F, (const unsigned*)(ws + WS_CTL) + CW_CNT + l * 32, true);
            ProbMoe1 p; p.A = ws + WS_ACT; p.W13 = ws + WS_EXP; p.H = ws + WS_H; p.toks = (const int*)(ws + WS_TOK);
            p.K = D; p.ntiles = (int)F.MISC[MW_TSTART + NEXP]; p.G = F.G; p.c = F.bid; p.misc = F.MISC;
            if (EN_MOE1) pg8::gemm_phase<ProbMoe1>(F.lds, p, F.tid);
            SEAM(pb + 7);
        }
        if (IN(pb + 8)) { ENTER();
            if (!args.fused) build_tiles(F, (const unsigned*)(ws + WS_CTL) + CW_CNT + l * 32, true);
            ProbMoe2 p; p.Hb = ws + WS_H; p.W2T = ws + WS_W2T; p.Y = ws + WS_Y;
            p.K = DE; p.ntiles = (int)F.MISC[MW_TSTART + NEXP]; p.G = F.G; p.c = F.bid; p.misc = F.MISC;
            if (EN_MOE2) pg8::gemm_phase<ProbMoe2>(F.lds, p, F.tid);
            SEAM(pb + 8);
        }
    }
    if (IN(PH_FINAL)) { ENTER(); if (EN_NORM1) phase_norm1(args, F, DEPTH); }
#undef IN
#undef SEAM
}

#ifndef MK_FUSED
#define MK_FUSED 1
#endif
extern "C" void kernel_launch(void* const* d_in, const int* in_sizes, int n_in, void* d_out, int out_size, void* d_ws, size_t ws_size, hipStream_t stream) {
    static int grid = 0;
    if (grid == 0) {
        if (n_in != N_IN || out_size != RL * D || ws_size < WS_END) { fprintf(stderr, "kernel_launch: unexpected shapes (n_in %d, out %d, ws %zu)\n", n_in, out_size, ws_size); grid = -1; return; }
        int dev = 0, cus = 0, per_cu = 0;
        if (hipGetDevice(&dev) != hipSuccess || hipDeviceGetAttribute(&cus, hipDeviceAttributeMultiprocessorCount, dev) != hipSuccess) { grid = -1; return; }
        if (hipFuncSetAttribute((const void*)fwd_kernel, hipFuncAttributeMaxDynamicSharedMemorySize, LDS_BYTES) != hipSuccess) { fprintf(stderr, "kernel_launch: hipFuncSetAttribute failed\n"); grid = -1; return; }
        if (hipOccupancyMaxActiveBlocksPerMultiprocessor(&per_cu, (const void*)fwd_kernel, 512, LDS_BYTES) != hipSuccess || per_cu < 1) { fprintf(stderr, "kernel_launch: occupancy query says %d\n", per_cu); }
        (void)hipGetLastError();
        grid = cus;
    }
    if (grid < 0) return;
    (void)hipMemsetAsync((char*)d_ws + WS_CTL, 0, CTL_BYTES, stream);
    Args a{};
    for (int i = 0; i < N_IN; ++i) a.in[i] = (const float*)d_in[i];
    a.out = (float*)d_out; a.ws = (unsigned char*)d_ws; a.pad = 0;
#if MK_FUSED
    a.ph_lo = 0; a.ph_hi = N_PHASES; a.fused = 1;
    hipLaunchKernelGGL(fwd_kernel, dim3(grid), dim3(512), LDS_BYTES, stream, a);
#else
    for (int ph = 0; ph < N_PHASES; ++ph) {
        if (ph >= 1 && ph < PH_FINAL) { const int k = (ph - 1) % 9, l = (ph - 1) / 9; if ((k == 3 || k == 4) && (l & 1)) continue; }
        a.ph_lo = ph; a.ph_hi = ph + 1; a.fused = 0;
        hipLaunchKernelGGL(fwd_kernel, dim3(grid), dim3(512), LDS_BYTES, stream, a);
    }
#endif
}
```

```cpp
#include <hip/hip_runtime.h>
#include <cstdio>
#include <cstdint>

#define LAS __attribute__((address_space(3)))
typedef unsigned short bf16_t;
typedef short bf16x8 __attribute__((ext_vector_type(8)));
typedef float f32x4 __attribute__((ext_vector_type(4)));
typedef float f32x2 __attribute__((ext_vector_type(2)));
typedef unsigned u32x4 __attribute__((ext_vector_type(4)));
typedef unsigned u32x2 __attribute__((ext_vector_type(2)));

constexpr int D = 1024, NB = 32, SEQ = 2048, LC = 256, DEPTH = 4;
constexpr int RC = NB * LC;
constexpr int RL = NB * SEQ;
constexpr int RT = RC + RL;
constexpr int EVSRC = 3104, EVN = 3072, EVNP = 3584, ODN = 3072, ODP = 2048;
constexpr int NEXP = 32, DE = 512;
constexpr int HYW = 512;
constexpr int PROWS = 2 * RT + NEXP * 256;
constexpr float EPS = 1e-6f;

constexpr size_t MiB = 1u << 20;
constexpr size_t WS_CTL = 0, CTL_BYTES = 1 * MiB;
constexpr size_t WS_MOD = 1 * MiB;
constexpr size_t WS_KR = 5 * MiB;
constexpr size_t WS_WEVIN = 14 * MiB;
constexpr size_t WS_WEVOUT = 28 * MiB;
constexpr size_t WS_WODIN = 32 * MiB;
constexpr size_t WS_WODOUT = 44 * MiB;
constexpr size_t WS_RW = 48 * MiB;
constexpr size_t WS_REC = 50 * MiB;
constexpr size_t WS_TOK = 52 * MiB;
constexpr size_t WS_H16 = 62 * MiB;
constexpr size_t WS_ACT = 206 * MiB;
constexpr size_t WS_P = 350 * MiB;
constexpr size_t WS_H = WS_P, WS_Y = WS_P + 152 * MiB;
constexpr size_t WS_EXP = 806 * MiB;
constexpr size_t WS_W2T = WS_EXP + 32 * MiB;
constexpr size_t WS_WT = WS_EXP;
constexpr size_t WS_OF = 902 * MiB, WS_OB = 974 * MiB;
constexpr size_t WS_X0T = 1046 * MiB;
constexpr size_t WS_G = 1126 * MiB;
constexpr size_t WS_END = 1198 * MiB;
static_assert((size_t)PROWS * 512 * 2 <= 152 * MiB && (size_t)PROWS * 1024 * 2 <= 304 * MiB && (size_t)RT * 3072 * 2 <= 456 * MiB, "ws map");

constexpr int CW_BAR = 4096;
constexpr int CW_CNT = 8192;
constexpr int CW_XQ = 10240;
constexpr int CW_DIAG = 12288;

constexpr int LDS_BYTES = 147456;
constexpr int LDS_MISC = 143360;
constexpr int MW_BAR = 0, MW_TSTART = 8, MW_CNT = 48, MW_HIST = 80, MW_TILE = 128;

typedef __bf16 bf16x2_t __attribute__((ext_vector_type(2)));
__device__ __forceinline__ unsigned pk2(float lo, float hi) { const f32x2 v = {lo, hi}; const bf16x2_t b = __builtin_convertvector(v, bf16x2_t); return __builtin_bit_cast(unsigned, b); }
__device__ __forceinline__ unsigned f2bf(float f) { return pk2(f, 0.0f) & 0xffffu; }
__device__ __forceinline__ unsigned pk4_fp8(float a, float b, float c, float d) {
    a = __builtin_amdgcn_fmed3f(a, -448.f, 448.f); b = __builtin_amdgcn_fmed3f(b, -448.f, 448.f); c = __builtin_amdgcn_fmed3f(c, -448.f, 448.f); d = __builtin_amdgcn_fmed3f(d, -448.f, 448.f);
    int w = 0; w = __builtin_amdgcn_cvt_pk_fp8_f32(a, b, w, false); w = __builtin_amdgcn_cvt_pk_fp8_f32(c, d, w, true); return (unsigned)w; }
__device__ __forceinline__ f32x4 up4_fp8(unsigned w) { const f32x2 lo = __builtin_amdgcn_cvt_pk_f32_fp8((int)w, false), hi = __builtin_amdgcn_cvt_pk_f32_fp8((int)w, true); return (f32x4){lo[0], lo[1], hi[0], hi[1]}; }
constexpr float SC_O = 4.0f;
constexpr float SC_Z = 8.0f, SC_WO = 32.0f;
constexpr int E8_Z = 0x7c7c7c7c, E8_WO = 0x7a7a7a7a;
constexpr float SC_V = 8.0f, SC_W13 = 64.0f, SC_H = 8.0f, SC_W2 = 32.0f, SC_Y = 32.0f;
constexpr int E8_V = 0x7c7c7c7c, E8_W13 = 0x79797979, E8_H = 0x7c7c7c7c, E8_W2 = 0x7a7a7a7a;
constexpr int E8_W13G = 0x7c7c7c7c, E8_W2Y = 0x7f7f7f7f;
__device__ __forceinline__ float bflo(unsigned w) { return __builtin_bit_cast(float, w << 16); }
__device__ __forceinline__ float bfhi(unsigned w) { return __builtin_bit_cast(float, w & 0xffff0000u); }
__device__ __forceinline__ float bf1(bf16_t b) { return __builtin_bit_cast(float, ((unsigned)b) << 16); }
__device__ __forceinline__ float wave_sum(float v) {
    v += __builtin_bit_cast(float, __builtin_amdgcn_update_dpp(0, __builtin_bit_cast(int, v), 0x111, 0xf, 0xf, false));
    v += __builtin_bit_cast(float, __builtin_amdgcn_update_dpp(0, __builtin_bit_cast(int, v), 0x112, 0xf, 0xf, false));
    v += __builtin_bit_cast(float, __builtin_amdgcn_update_dpp(0, __builtin_bit_cast(int, v), 0x114, 0xf, 0xf, false));
    v += __builtin_bit_cast(float, __builtin_amdgcn_update_dpp(0, __builtin_bit_cast(int, v), 0x118, 0xf, 0xf, false));
    v += __builtin_bit_cast(float, __builtin_amdgcn_update_dpp(0, __builtin_bit_cast(int, v), 0x142, 0xa, 0xf, false));
    v += __builtin_bit_cast(float, __builtin_amdgcn_update_dpp(0, __builtin_bit_cast(int, v), 0x143, 0xc, 0xf, false));
    return __builtin_bit_cast(float, __builtin_amdgcn_readlane(__builtin_bit_cast(int, v), 63));
}
__device__ __forceinline__ float silu_f(float x) { return x * __builtin_amdgcn_rcpf(1.0f + __expf(-x)); }
#define LDS_WAIT() asm volatile("s_waitcnt lgkmcnt(0)" ::: "memory")
#define VM_WAIT() asm volatile("s_waitcnt vmcnt(0)" ::: "memory")

__device__ __forceinline__ int lat_row(int b, int j, bool cm) { const int s = cm ? ((j & 31) * 64 + (j >> 5)) : j; return RC + b * SEQ + s; }
__device__ __forceinline__ int seq_nbr(int row, int dlt, bool cm) {
    if (row < RC) { const int b = row >> 8, p = (row & 255) + dlt; return (p < 0 || p >= LC) ? -1 : (b * LC + p); }
    const int r = row - RC, b = r >> 11, s = r & 2047;
    const int j = (cm ? ((s & 63) * 32 + (s >> 6)) : s) + dlt;
    return (j < 0 || j >= SEQ) ? -1 : lat_row(b, j, cm);
}

#define XB_TMO      128
#define XB_XCNT(j)  (256  + 64 * (j))
#define XB_XSUB(j)  (1280 + 64 * (j))
#define XB_XGEN(j)  (2304 + 64 * (j))
#define XB_TOP      3328
#define XB_TOPGEN   3392
#define XCD_BAR_WORDS 3456
#define XB_SPIN_CAP (1u << 22)

__device__ __forceinline__ unsigned xb_ld(unsigned* p)              { return __hip_atomic_load(p, __ATOMIC_RELAXED, __HIP_MEMORY_SCOPE_AGENT); }
__device__ __forceinline__ unsigned xb_add(unsigned* p, unsigned v) { return __hip_atomic_fetch_add(p, v, __ATOMIC_RELAXED, __HIP_MEMORY_SCOPE_AGENT); }
__device__ __forceinline__ unsigned xb_xcc_id() { return (unsigned)__builtin_amdgcn_s_getreg((3 << 11) | 20) & 0xFu; }
#define XB_SPIN(cond, bar) do { unsigned _sp = 0; while (cond) { __builtin_amdgcn_s_sleep(1); \
    if ((++_sp & 255u) == 0u) { if (xb_ld(&(bar)[XB_TMO])) break; if (_sp > XB_SPIN_CAP) { atomicAdd(&(bar)[XB_TMO], 1u); break; } } } } while (0)

struct XcdBarrier { unsigned* bar; unsigned x; volatile LAS unsigned* st; };

__device__ __forceinline__ XcdBarrier xcd_barrier_post(unsigned* bar, volatile LAS unsigned* st) {
    XcdBarrier b; b.bar = bar; b.x = xb_xcc_id(); b.st = st;
    if (threadIdx.x == 0) (void)xb_add(&bar[XB_XCNT(b.x)], 1u);
    return b;
}
__device__ __forceinline__ void xcd_barrier_complete(unsigned* bar, unsigned x, unsigned& nloc, unsigned& nx) {
    const unsigned G = gridDim.x * gridDim.y * gridDim.z;
    unsigned sum, cnt, mine, sp = 0u;
    for (;;) {
        sum = 0u; cnt = 0u; mine = 0u;
#pragma unroll
        for (unsigned j = 0; j < 16; ++j) { const unsigned c = xb_ld(&bar[XB_XCNT(j)]); sum += c; cnt += (c > 0u) ? 1u : 0u; mine = (j == x) ? c : mine; }
        if (sum == G) break;
        __builtin_amdgcn_s_sleep(1);
        if ((++sp & 255u) == 0u) { if (xb_ld(&bar[XB_TMO])) break; if (sp > XB_SPIN_CAP) { atomicAdd(&bar[XB_TMO], 1u); break; } }
    }
    nloc = mine > 0u ? mine : 1u; nx = cnt > 0u ? cnt : 1u;
}
__device__ __forceinline__ void xcd_barrier(const XcdBarrier& b) {
    asm volatile("s_waitcnt vmcnt(0)" ::: "memory");
    __syncthreads();
    if (threadIdx.x == 0) {
        unsigned* bar = b.bar;
        __builtin_amdgcn_s_waitcnt(0);
        unsigned nloc = b.st[0], nx = b.st[1];
        if (nloc == 0u) { xcd_barrier_complete(bar, b.x, nloc, nx); b.st[0] = nloc; b.st[1] = nx; }
        const unsigned old = xb_add(&bar[XB_XSUB(b.x)], 1u);
        const unsigned gen = old / nloc;
        if (old + 1u == (gen + 1u) * nloc) {
            __builtin_amdgcn_fence(__ATOMIC_RELEASE, "agent");
            asm volatile("s_waitcnt vmcnt(0)" ::: "memory");
            const unsigned og = xb_add(&bar[XB_TOP], 1u);
            const unsigned tg = og / nx;
            if (og + 1u == (tg + 1u) * nx) xb_add(&bar[XB_TOPGEN], 1u);
            else XB_SPIN(xb_ld(&bar[XB_TOPGEN]) == tg, bar);
            __builtin_amdgcn_fence(__ATOMIC_ACQUIRE, "agent");
            xb_add(&bar[XB_XGEN(b.x)], 1u);
            asm volatile("s_waitcnt vmcnt(0)" ::: "memory");
        } else {
            XB_SPIN(xb_ld(&bar[XB_XGEN(b.x)]) == gen, bar);
            __builtin_amdgcn_fence(__ATOMIC_ACQUIRE, "agent");
            asm volatile("s_waitcnt vmcnt(0)" ::: "memory");
        }
    }
    __syncthreads();
}

enum { I_X = 0, I_C, I_CTX, I_CCTX, I_MODW, I_MODB, I_NMIX, I_NFFN, I_NFIN, I_EVWIN, I_EVWOUT, I_WAF, I_BAF, I_WAB, I_BAB, I_GLAN,
       I_HYCW, I_HYCB, I_HYW1, I_HYB1, I_HYF1, I_HYW2, I_HYB2, I_HYF2, I_HYW3, I_HYSKIP, I_ODWIN, I_ODCW, I_ODWOUT,
       I_RTWG, I_RTBG, I_RTWE, I_RTBE, I_EXW1, I_EXW3, I_EXW2, N_IN };
struct Args { const float* in[N_IN]; float* out; unsigned char* ws; int ph_lo, ph_hi, fused, pad; };

struct Frame {
    LAS unsigned char* lds;
    volatile LAS unsigned* MISC;
    int tid, lane, wave, G, bid, z;
    unsigned char* ws;
};

namespace pg8 {
constexpr int BM = 256, BK = 64, HALF = 128, HTB = HALF * BK * 2, STAGE_BYTES = 8 * HTB, NXCD = 8, WGM = 8;
__device__ __forceinline__ int lds_byte(int r, int c) { const int st = (r >> 4) * 2 + (c >> 5), rr = r & 15, cc = c & 31, ob = rr * 64 + cc * 2; return st * 1024 + (ob ^ (((ob >> 9) & 1) << 5)); }
__device__ __forceinline__ void stage_rc(int b, int& R, int& C) { const int st = b / 1024, sb = b % 1024, swz = sb ^ (((sb >> 9) & 1) << 5); R = (st >> 1) * 16 + swz / 64; C = (st & 1) * 32 + (swz % 64) / 2; }
__device__ __forceinline__ int perm32(int rho) { const int n = rho >> 4, i = rho & 15; return 8 * (i >> 2) + 4 * n + (i & 3); }
__device__ __forceinline__ unsigned cvt_pk_bf16(float lo, float hi) { return pk2(lo, hi); }

struct Unit { const char* A; const char* B; int pm, pn; };
__device__ __forceinline__ bool order_next(int i, int G, int c, int nM, int nN, int& pm, int& pn) {
    const int nwg = nM * nN; const long L = (long)i * G + c; if (L >= nwg) return false;
    int wgid = (int)L; { const int q = nwg / NXCD, r = nwg % NXCD, xcd = wgid % NXCD, off = wgid / NXCD; wgid = (xcd < r ? xcd * (q + 1) : r * (q + 1) + (xcd - r) * q) + off; }
    const int nig = WGM * nN, gid = wgid / nig, fm = gid * WGM, gsz = (nM - fm) < WGM ? (nM - fm) : WGM;
    pm = fm + ((wgid % nig) % gsz); pn = (wgid % nig) / gsz; return true;
}

typedef int i32x8 __attribute__((ext_vector_type(8)));
typedef int i32x4 __attribute__((ext_vector_type(4)));
__device__ __forceinline__ i32x8 cat8(bf16x8 a, bf16x8 b) { const i32x4 x = __builtin_bit_cast(i32x4, a), y = __builtin_bit_cast(i32x4, b); return __builtin_shufflevector(x, y, 0, 1, 2, 3, 4, 5, 6, 7); }
template <class P>
__device__ __forceinline__ void gemm_phase(LAS unsigned char* lds, const P& pr, const int tid) {
    const int wid = __builtin_amdgcn_readfirstlane(tid >> 6), lane = tid & 63, wr = wid >> 2, wc = wid & 3, fr = lane & 15, fq = lane >> 4;
    const int KB = P::FP8 ? pr.K : 2 * pr.K;
    const int nt = KB / 128;
    unsigned voffB[2], Rr[2], Cb[2];
#pragma unroll
    for (int i = 0; i < 2; ++i) { int R, C; stage_rc(tid * 16 + i * 8192, R, C);
        const int Rb = P::PERM16 ? (64 * (R >> 5) + 16 * ((R & 15) >> 2) + 4 * ((R >> 4) & 1) + (R & 3)) : (P::PERM ? ((R & ~31) + perm32(R & 31)) : R);
        voffB[i] = (unsigned)(Rb * KB + C * 2); Rr[i] = (unsigned)R; Cb[i] = (unsigned)C * 2u; }
    const size_t kstep = (size_t)128;
    const size_t hstep = (size_t)(P::PERM16 ? 8 : HALF) * KB;
    const unsigned ldsw = (unsigned)wid * 1024u;
    const int aoff = lds_byte(wr * 64 + fr, fq * 8), boff = lds_byte(wc * 32 + fr, fq * 8);
#define PG8_SA(b, h) (((b) * 2 + (h)) * HTB)
#define PG8_SB(b, h) ((4 + (b) * 2 + (h)) * HTB)
#define PG8_STAGE(bufoff, gbase, voff) do { const char* _gb = (const char*)(gbase); asm volatile("" : "+s"(_gb)); _Pragma("unroll") for (int _i = 0; _i < 2; ++_i) \
        __builtin_amdgcn_global_load_lds((const unsigned*)(_gb + (voff)[_i]), (LAS unsigned*)(lds + (bufoff) + ldsw + _i * 8192), 16, 0, 0); } while (0)
#define PG8_LDA(dst, b, h) do { _Pragma("unroll") for (int m = 0; m < 4; ++m) _Pragma("unroll") for (int k = 0; k < 2; ++k) dst[m][k] = *(const LAS bf16x8*)(lds + PG8_SA(b, h) + aoff + m * 2048 + k * 1024); } while (0)
#define PG8_LDB(dst, b, h) do { _Pragma("unroll") for (int n = 0; n < 2; ++n) _Pragma("unroll") for (int k = 0; k < 2; ++k) dst[n][k] = *(const LAS bf16x8*)(lds + PG8_SB(b, h) + boff + n * 2048 + k * 1024); } while (0)
#define PG8_MMA(ai, bj, At, Bt) do { __builtin_amdgcn_s_setprio(1); _Pragma("unroll") for (int m = 0; m < 4; ++m) _Pragma("unroll") for (int n = 0; n < 2; ++n) { \
        if constexpr (P::FP8) { const i32x8 _w = cat8(Bt[n][0], Bt[n][1]), _x = cat8(At[m][0], At[m][1]); \
            asm volatile("v_mfma_scale_f32_16x16x128_f8f6f4 %0, %1, %2, %0, %3, %4 op_sel_hi:[0,0,0]" : "+v"(acc[ai][bj][m][n]) : "v"(_w), "v"(_x), "v"((bj) ? scw1_ : scw_), "v"(scx_)); } \
        else { _Pragma("unroll") for (int k = 0; k < 2; ++k) acc[ai][bj][m][n] = __builtin_amdgcn_mfma_f32_16x16x32_bf16(Bt[n][k], At[m][k], acc[ai][bj][m][n], 0, 0, 0); } } \
        __builtin_amdgcn_s_setprio(0); } while (0)
#define PG8_WAIT_V(n) asm volatile("s_waitcnt vmcnt(" #n ")" ::: "memory")
#define PG8_WAIT_L(n) asm volatile("s_waitcnt lgkmcnt(" #n ")" ::: "memory")
#define PG8_BAR __builtin_amdgcn_s_barrier()
#define PG8_SCHED __builtin_amdgcn_sched_barrier(0)
    int scw_ = P::SCW, scw1_ = P::SCW1, scx_ = P::SCX; asm volatile("" : "+v"(scw_), "+v"(scw1_), "+v"(scx_));
    Unit cur, nxt; int ui = 0;
    if (!pr.next(0, cur)) return;
    unsigned vc[2][2], vn[2][2];
#pragma unroll
    for (int h = 0; h < 2; ++h)
#pragma unroll
        for (int i = 0; i < 2; ++i) {
            if constexpr (P::GATHER) vc[h][i] = pr.row_id(cur, h * HALF + (int)Rr[i]) * (unsigned)KB + Cb[i];
            else vc[h][i] = (unsigned)((h * HALF + (int)Rr[i]) * KB) + Cb[i];
            vn[h][i] = vc[h][i];
        }
    f32x4 acc[2][2][4][2];
#pragma unroll
    for (int a = 0; a < 2; ++a)
#pragma unroll
        for (int b = 0; b < 2; ++b)
#pragma unroll
            for (int m = 0; m < 4; ++m)
#pragma unroll
                for (int n = 0; n < 2; ++n) acc[a][b][m][n] = (f32x4){0.f, 0.f, 0.f, 0.f};
    bf16x8 At[4][2], B0[2][2], B1[2][2];
    const char* cA = cur.A; const char* cB = cur.B;
    PG8_STAGE(PG8_SB(0, 0), cB, voffB); PG8_STAGE(PG8_SA(0, 0), cA, vc[0]); PG8_STAGE(PG8_SB(0, 1), cB + hstep, voffB); PG8_STAGE(PG8_SA(0, 1), cA, vc[1]);
    if (wr == 1) PG8_BAR;
    PG8_WAIT_V(4); PG8_BAR;
    PG8_STAGE(PG8_SB(1, 0), cB + kstep, voffB); PG8_STAGE(PG8_SA(1, 0), cA + kstep, vc[0]); PG8_STAGE(PG8_SB(1, 1), cB + hstep + kstep, voffB);
    PG8_WAIT_V(6); PG8_BAR;
    unsigned nid[2][2] = {{0u, 0u}, {0u, 0u}};
    for (;;) {
        const bool has_next = pr.next(ui + 1, nxt);
        const char* nA = has_next ? nxt.A : cA; const char* nB = has_next ? nxt.B : cB;
        for (int t = 0; t < nt; t += 2) {
            const bool last = (t == nt - 2);
            if constexpr (P::GATHER) {
                LAS unsigned* mbox = (LAS unsigned*)(lds + STAGE_BYTES) + wid * 256;
                if (has_next && t == nt - 4) {
#pragma unroll
                    for (int h = 0; h < 2; ++h)
#pragma unroll
                        for (int i = 0; i < 2; ++i) __builtin_amdgcn_global_load_lds((const unsigned*)pr.row_id_ptr(nxt, h * HALF + (int)Rr[i]), mbox + (h * 2 + i) * 64, 4, 0, 0);
                }
                if (has_next && last) {
#pragma unroll
                    for (int h = 0; h < 2; ++h)
#pragma unroll
                        for (int i = 0; i < 2; ++i) { nid[h][i] = mbox[(h * 2 + i) * 64 + lane]; vn[h][i] = nid[h][i] * (unsigned)KB + Cb[i]; }
                }
            }
            unsigned v2[2][2];
#pragma unroll
            for (int h = 0; h < 2; ++h)
#pragma unroll
                for (int i = 0; i < 2; ++i) v2[h][i] = last ? vn[h][i] : vc[h][i];
            const char* a1 = cA + (size_t)(t + 1) * kstep;
            const char* a2 = last ? nA : cA + (size_t)(t + 2) * kstep; const char* b2 = last ? nB : cB + (size_t)(t + 2) * kstep;
            const char* a3 = a2 + kstep; const char* b3 = b2 + kstep;
            PG8_LDB(B0, 0, 0); PG8_SCHED; PG8_LDA(At, 0, 0); PG8_STAGE(PG8_SA(1, 1), a1, vc[1]);
            PG8_WAIT_L(8); PG8_BAR; PG8_WAIT_L(0); PG8_MMA(0, 0, At, B0); PG8_BAR; PG8_SCHED;
            PG8_LDB(B1, 0, 1); PG8_STAGE(PG8_SB(0, 0), b2, voffB);
            PG8_BAR; PG8_WAIT_L(0); PG8_MMA(0, 1, At, B1); PG8_BAR;
            PG8_LDA(At, 0, 1); PG8_STAGE(PG8_SA(0, 0), a2, v2[0]);
            PG8_BAR; PG8_WAIT_L(0); PG8_MMA(1, 0, At, B0); PG8_BAR; PG8_SCHED;
            PG8_STAGE(PG8_SB(0, 1), b2 + hstep, voffB);
            PG8_WAIT_V(6); PG8_BAR; PG8_MMA(1, 1, At, B1); PG8_BAR;
            PG8_LDB(B0, 1, 0); PG8_SCHED; PG8_LDA(At, 1, 0); PG8_STAGE(PG8_SA(0, 1), a2, v2[1]);
            PG8_WAIT_L(8); PG8_BAR; PG8_WAIT_L(0); PG8_MMA(0, 0, At, B0); PG8_BAR; PG8_SCHED;
            PG8_LDB(B1, 1, 1); PG8_STAGE(PG8_SB(1, 0), b3, voffB);
            PG8_BAR; PG8_WAIT_L(0); PG8_MMA(0, 1, At, B1); PG8_BAR;
            PG8_LDA(At, 1, 1); PG8_STAGE(PG8_SA(1, 0), a3, v2[0]);
            PG8_BAR; PG8_WAIT_L(0); PG8_MMA(1, 0, At, B0); PG8_BAR; PG8_SCHED;
            PG8_STAGE(PG8_SB(1, 1), b3 + hstep, voffB);
            PG8_WAIT_V(6); PG8_BAR; PG8_MMA(1, 1, At, B1); PG8_BAR;
        }
        if constexpr (P::FP8) asm volatile("s_nop 7\n\ts_nop 7\n\ts_nop 3" ::: "memory");
        { int zz; asm volatile("s_mov_b32 %0, 0" : "=s"(zz));
          pr.epi(acc, cur, wr, wc, fr + zz, fq); }
        if (!has_next) break;
#pragma unroll
        for (int a = 0; a < 2; ++a)
#pragma unroll
            for (int b = 0; b < 2; ++b)
#pragma unroll
                for (int m = 0; m < 4; ++m)
#pragma unroll
                    for (int n = 0; n < 2; ++n) acc[a][b][m][n] = (f32x4){0.f, 0.f, 0.f, 0.f};
        cur = nxt; cA = nA; cB = nB; ++ui;
#pragma unroll
        for (int h = 0; h < 2; ++h)
#pragma unroll
            for (int i = 0; i < 2; ++i) vc[h][i] = vn[h][i];
    }
    PG8_WAIT_V(0);
    if (wr == 0) PG8_BAR;
    PG8_BAR;
#undef PG8_SA
#undef PG8_SB
#undef PG8_STAGE
#undef PG8_LDA
#undef PG8_LDB
#undef PG8_MMA
#undef PG8_WAIT_V
#undef PG8_WAIT_L
#undef PG8_BAR
#undef PG8_SCHED
}
}

struct ProbIn {
    static constexpr bool PERM = true, PERM16 = false, GATHER = false, FP8 = false; static constexpr int SCW = 0, SCW1 = 0, SCX = 0;
    const bf16_t* A; const bf16_t* Bt; bf16_t* O; int K, nM, nN, ncols, ldc, row0, G, c;
    int prod0;
    bf16_t* Gd; const float* gbf; const float* gbb;
    __device__ __forceinline__ bool next(int i, pg8::Unit& u) const {
        if (!pg8::order_next(i, G, c, nM, nN, u.pm, u.pn)) return false;
        u.A = (const char*)(A + (size_t)(row0 + u.pm * 256) * K); u.B = (const char*)(Bt + (size_t)(u.pn * 256) * K); return true; }
    __device__ __forceinline__ unsigned row_id(const pg8::Unit&, int) const { return 0u; }
    __device__ __forceinline__ const int* row_id_ptr(const pg8::Unit&, int) const { return nullptr; }
    __device__ __forceinline__ void epi(const f32x4 (&acc)[2][2][4][2], const pg8::Unit& u, int wr, int wc, int fr, int fq) const {
        const int rowb = row0 + u.pm * 256 + wr * 64 + fr, colb = u.pn * 256 + wc * 32 + 8 * fq;
        if (u.pn * 256 >= prod0) {
            const int col = prod0 + (u.pn - (prod0 >> 8)) * 128 + wc * 32 + 8 * fq;
#pragma unroll
            for (int ai = 0; ai < 2; ++ai)
#pragma unroll
                for (int m = 0; m < 4; ++m) { const f32x4 a0 = acc[ai][0][m][0] * acc[ai][1][m][0], a1 = acc[ai][0][m][1] * acc[ai][1][m][1];
                    u32x4 w; w.x = pg8::cvt_pk_bf16(a0[0], a0[1]); w.y = pg8::cvt_pk_bf16(a0[2], a0[3]); w.z = pg8::cvt_pk_bf16(a1[0], a1[1]); w.w = pg8::cvt_pk_bf16(a1[2], a1[3]);
                    *(u32x4*)(O + (size_t)(rowb + ai * 128 + m * 16) * ldc + col) = w; }
        } else if (colb < ncols) {
            const char* tb = (const char*)(O + (size_t)(row0 + u.pm * 256) * ldc + u.pn * 256);
            const unsigned lo0 = (unsigned)((wr * 64 + fr) * ldc + wc * 32 + 8 * fq) * 2u; const unsigned rstep = (unsigned)ldc * 32u;
#pragma unroll
            for (int ai = 0; ai < 2; ++ai)
#pragma unroll
                for (int m = 0; m < 4; ++m) { const unsigned ro = lo0 + (unsigned)(ai * 8 + m) * rstep;
#pragma unroll
                    for (int bj = 0; bj < 2; ++bj) { const f32x4 v0 = acc[ai][bj][m][0], v1 = acc[ai][bj][m][1];
                        u32x4 w; w.x = pg8::cvt_pk_bf16(v0[0], v0[1]); w.y = pg8::cvt_pk_bf16(v0[2], v0[3]); w.z = pg8::cvt_pk_bf16(v1[0], v1[1]); w.w = pg8::cvt_pk_bf16(v1[2], v1[3]);
                        *(u32x4*)(tb + (ro + (unsigned)bj * 256u)) = w; } }
        } else {
            const int gc = colb - ncols;
            const float* bp = (gc < 256) ? gbf + gc : gbb + (gc - 256);
            f32x4 bv[2][2];
#pragma unroll
            for (int bj = 0; bj < 2; ++bj)
#pragma unroll
                for (int n = 0; n < 2; ++n) bv[bj][n] = *(const f32x4*)(bp + bj * 128 + 4 * n);
#pragma unroll
            for (int ai = 0; ai < 2; ++ai)
#pragma unroll
                for (int m = 0; m < 4; ++m) { bf16_t* rowp = Gd + (size_t)(rowb + ai * 128 + m * 16) * 512 + gc;
#pragma unroll
                    for (int bj = 0; bj < 2; ++bj) { float o[8];
#pragma unroll
                        for (int n = 0; n < 2; ++n)
#pragma unroll
                            for (int j = 0; j < 4; ++j) { const float z = acc[ai][bj][m][n][j] + bv[bj][n][j]; o[n * 4 + j] = (fminf(z, 0.f) - __logf(1.0f + __expf(-fabsf(z)))) * (1.0f / 16.0f); }
                        u32x4 w; w.x = pg8::cvt_pk_bf16(o[0], o[1]); w.y = pg8::cvt_pk_bf16(o[2], o[3]); w.z = pg8::cvt_pk_bf16(o[4], o[5]); w.w = pg8::cvt_pk_bf16(o[6], o[7]);
                        *(u32x4*)(rowp + bj * 128) = w; } }
        }
    }
};
template <bool F8> struct ProbOut {
    static constexpr bool PERM = true, PERM16 = false, GATHER = false, FP8 = F8; static constexpr int SCW = E8_WO, SCW1 = E8_WO, SCX = E8_Z;
    const unsigned char* A; const unsigned char* Bt; int K, nM, nN, row0, G, c;
    const float* x_c; const float* x_l; int first; bf16_t* H16; const float* gate;
    __device__ __forceinline__ bool next(int i, pg8::Unit& u) const {
        if (!pg8::order_next(i, G, c, nM, nN, u.pm, u.pn)) return false;
        constexpr int EB = F8 ? 1 : 2;
        u.A = (const char*)(A + (size_t)(row0 + u.pm * 256) * K * EB); u.B = (const char*)(Bt + (size_t)(u.pn * 256) * K * EB); return true; }
    __device__ __forceinline__ unsigned row_id(const pg8::Unit&, int) const { return 0u; }
    __device__ __forceinline__ const int* row_id_ptr(const pg8::Unit&, int) const { return nullptr; }
    __device__ __forceinline__ void epi(const f32x4 (&acc)[2][2][4][2], const pg8::Unit& u, int wr, int wc, int fr, int fq) const {
        const int tile0 = row0 + u.pm * 256;
        const int b = tile0 < RC ? NB : ((tile0 - RC) >> 11);
        const float* xs = tile0 < RC ? x_c + (size_t)tile0 * D : x_l + (size_t)(tile0 - RC) * D;
        bf16_t* hp = H16 + (size_t)tile0 * D;
        const int col0 = u.pn * 256 + wc * 32 + 8 * fq; const float* gp = gate + (size_t)b * 6144 + col0;
        f32x4 gv[2][2];
#pragma unroll
        for (int bj = 0; bj < 2; ++bj)
#pragma unroll
            for (int n = 0; n < 2; ++n) gv[bj][n] = *(const f32x4*)(gp + bj * 128 + 4 * n);
        if (!first) {
#pragma unroll
            for (int ai = 0; ai < 2; ++ai) {
                u32x4 hw[4][2];
#pragma unroll
                for (int m = 0; m < 4; ++m)
#pragma unroll
                    for (int bj = 0; bj < 2; ++bj) hw[m][bj] = *(const u32x4*)(hp + (size_t)(wr * 64 + fr + ai * 128 + m * 16) * D + col0 + bj * 128);
                __builtin_amdgcn_sched_barrier(0);
#pragma unroll
                for (int m = 0; m < 4; ++m) { const size_t off = (size_t)(wr * 64 + fr + ai * 128 + m * 16) * D + col0;
#pragma unroll
                    for (int bj = 0; bj < 2; ++bj) { const u32x4 w = hw[m][bj];
                        f32x4 s0 = (f32x4){bflo(w.x), bfhi(w.x), bflo(w.y), bfhi(w.y)}, s1 = (f32x4){bflo(w.z), bfhi(w.z), bflo(w.w), bfhi(w.w)};
                        s0 = s0 + gv[bj][0] * acc[ai][bj][m][0]; s1 = s1 + gv[bj][1] * acc[ai][bj][m][1];
                        u32x4 o; o.x = pg8::cvt_pk_bf16(s0[0], s0[1]); o.y = pg8::cvt_pk_bf16(s0[2], s0[3]); o.z = pg8::cvt_pk_bf16(s1[0], s1[1]); o.w = pg8::cvt_pk_bf16(s1[2], s1[3]);
                        *(u32x4*)(hp + off + bj * 128) = o; } }
                __builtin_amdgcn_sched_barrier(0);
            }
        } else {
#pragma unroll
            for (int am = 0; am < 4; ++am) { const int ai = am >> 1, m0 = (am & 1) * 2;
                f32x4 xw[2][2][2];
#pragma unroll
                for (int mm = 0; mm < 2; ++mm)
#pragma unroll
                    for (int bj = 0; bj < 2; ++bj) { const float* xp = xs + (size_t)(wr * 64 + fr + ai * 128 + (m0 + mm) * 16) * D + col0 + bj * 128; xw[mm][bj][0] = *(const f32x4*)xp; xw[mm][bj][1] = *(const f32x4*)(xp + 4); }
                __builtin_amdgcn_sched_barrier(0);
#pragma unroll
                for (int mm = 0; mm < 2; ++mm) { const int m = m0 + mm; const size_t off = (size_t)(wr * 64 + fr + ai * 128 + m * 16) * D + col0;
#pragma unroll
                    for (int bj = 0; bj < 2; ++bj) {
                        const f32x4 s0 = xw[mm][bj][0] + gv[bj][0] * acc[ai][bj][m][0], s1 = xw[mm][bj][1] + gv[bj][1] * acc[ai][bj][m][1];
                        u32x4 o; o.x = pg8::cvt_pk_bf16(s0[0], s0[1]); o.y = pg8::cvt_pk_bf16(s0[2], s0[3]); o.z = pg8::cvt_pk_bf16(s1[0], s1[1]); o.w = pg8::cvt_pk_bf16(s1[2], s1[3]);
                        *(u32x4*)(hp + off + bj * 128) = o; } }
                __builtin_amdgcn_sched_barrier(0);
            }
        }
    }
};
struct ProbMoe1 {
    static constexpr bool PERM = true, PERM16 = false, GATHER = true, FP8 = true; static constexpr int SCW = E8_W13, SCW1 = E8_W13G, SCX = E8_V;
    const unsigned char* A; const unsigned char* W13; unsigned char* H; const int* toks; int K, ntiles, G, c;
    const volatile LAS unsigned* misc;
    __device__ __forceinline__ bool next(int i, pg8::Unit& u) const {
        if (!pg8::order_next(i, G, c, ntiles, 4, u.pm, u.pn)) return false;
        const int e = __builtin_amdgcn_readfirstlane((int)misc[MW_TILE + u.pm]);
        u.A = (const char*)A; u.B = (const char*)(W13 + ((size_t)e * 1024 + u.pn * 256) * 1024); return true; }
    __device__ __forceinline__ unsigned row_id(const pg8::Unit& u, int r) const {
        const int e = __builtin_amdgcn_readfirstlane((int)misc[MW_TILE + u.pm]); const int r0 = (u.pm - __builtin_amdgcn_readfirstlane((int)misc[MW_TSTART + e])) * 256; const int cnt = __builtin_amdgcn_readfirstlane((int)misc[MW_CNT + e]);
        int idx = r0 + r; idx = idx < cnt ? idx : cnt - 1;
        return (unsigned)toks[(size_t)e * RT + idx]; }
    __device__ __forceinline__ const int* row_id_ptr(const pg8::Unit& u, int r) const {
        const int e = __builtin_amdgcn_readfirstlane((int)misc[MW_TILE + u.pm]); const int r0 = (u.pm - __builtin_amdgcn_readfirstlane((int)misc[MW_TSTART + e])) * 256; const int cnt = __builtin_amdgcn_readfirstlane((int)misc[MW_CNT + e]);
        int idx = r0 + r; idx = idx < cnt ? idx : cnt - 1;
        return toks + (size_t)e * RT + idx; }
    __device__ __forceinline__ void epi(const f32x4 (&acc)[2][2][4][2], const pg8::Unit& u, int wr, int wc, int fr, int fq) const {
        const int rowb = u.pm * 256 + wr * 64 + fr, col = u.pn * 128 + wc * 32 + 8 * fq;
#pragma unroll
        for (int ai = 0; ai < 2; ++ai)
#pragma unroll
            for (int m = 0; m < 4; ++m) { unsigned char* rowp = H + (size_t)(rowb + ai * 128 + m * 16) * DE + col;
                float o[8];
#pragma unroll
                for (int n = 0; n < 2; ++n)
#pragma unroll
                    for (int j = 0; j < 4; j += 2) { const f32x2 a2 = {acc[ai][0][m][n][j], acc[ai][0][m][n][j + 1]}, g2 = {acc[ai][1][m][n][j], acc[ai][1][m][n][j + 1]};
                        const f32x2 t2 = a2 * (-1.44269504089f);
                        f32x2 r2; r2.x = __builtin_amdgcn_rcpf(1.0f + __builtin_amdgcn_exp2f(t2.x)); r2.y = __builtin_amdgcn_rcpf(1.0f + __builtin_amdgcn_exp2f(t2.y));
                        const f32x2 o2 = (a2 * r2) * g2; o[n * 4 + j] = o2.x; o[n * 4 + j + 1] = o2.y; }
                u32x2 w; w.x = pk4_fp8(o[0], o[1], o[2], o[3]); w.y = pk4_fp8(o[4], o[5], o[6], o[7]);
                *(u32x2*)rowp = w; }
    }
};
struct ProbMoe2 {
    static constexpr bool PERM = true, PERM16 = true, GATHER = false, FP8 = true; static constexpr int SCW = E8_W2Y, SCW1 = E8_W2Y, SCX = E8_H;
    const unsigned char* Hb; const unsigned char* W2T; unsigned char* Y; int K, ntiles, G, c;
    const volatile LAS unsigned* misc;
    __device__ __forceinline__ bool next(int i, pg8::Unit& u) const {
        if (!pg8::order_next(i, G, c, ntiles, 4, u.pm, u.pn)) return false;
        const int e = __builtin_amdgcn_readfirstlane((int)misc[MW_TILE + u.pm]);
        u.A = (const char*)(Hb + (size_t)u.pm * 256 * DE); u.B = (const char*)(W2T + ((size_t)e * 1024 + u.pn * 256) * DE); return true; }
    __device__ __forceinline__ unsigned row_id(const pg8::Unit&, int) const { return 0u; }
    __device__ __forceinline__ const int* row_id_ptr(const pg8::Unit&, int) const { return nullptr; }
    __device__ __forceinline__ void epi(const f32x4 (&acc)[2][2][4][2], const pg8::Unit& u, int wr, int wc, int fr, int fq) const {
        const int rowb = u.pm * 256 + wr * 64 + fr, colb = u.pn * 256 + wc * 64 + 16 * fq;
#pragma unroll
        for (int ai = 0; ai < 2; ++ai)
#pragma unroll
            for (int m = 0; m < 4; ++m) { unsigned char* rowp = Y + (size_t)(rowb + ai * 128 + m * 16) * D;
                u32x4 w;
                { const f32x4 v0 = acc[ai][0][m][0], v1 = acc[ai][0][m][1], v2 = acc[ai][1][m][0], v3 = acc[ai][1][m][1];
                  w.x = pk4_fp8(v0[0], v0[1], v0[2], v0[3]); w.y = pk4_fp8(v1[0], v1[1], v1[2], v1[3]); w.z = pk4_fp8(v2[0], v2[1], v2[2], v2[3]); w.w = pk4_fp8(v3[0], v3[1], v3[2], v3[3]); }
                *(u32x4*)(rowp + colb) = w; }
    }
};

__device__ __forceinline__ void transpose_tile(const float* W, int ldw, bf16_t* dst, int ldd, LAS float* scr, int lane) {
#pragma unroll 8
    for (int i = 0; i < 32; ++i) { const int kk = 2 * i + (lane >> 5); scr[kk * 33 + (lane & 31)] = W[(size_t)kk * ldw + (lane & 31)]; }
    LDS_WAIT(); asm volatile("" ::: "memory");
    const int c = lane & 7;
#pragma unroll
    for (int j = 0; j < 4; ++j) { const int n = (lane >> 3) + 8 * j; const LAS float* s = scr + (8 * c) * 33 + n;
        u32x4 o; o.x = pk2(s[0 * 33], s[1 * 33]); o.y = pk2(s[2 * 33], s[3 * 33]); o.z = pk2(s[4 * 33], s[5 * 33]); o.w = pk2(s[6 * 33], s[7 * 33]);
        *(u32x4*)(dst + (size_t)n * ldd + 8 * c) = o; }
    LDS_WAIT(); asm volatile("" ::: "memory");
}
__device__ __forceinline__ void transpose_item(const float* W, int K, int N, bf16_t* WT, LAS float* scr, int it, int lane) {
    const int nblk = N / 32, kb = it / nblk, nb = it % nblk;
    transpose_tile(W + (size_t)(kb * 64) * N + nb * 32, N, WT + (size_t)(nb * 32) * K + kb * 64, K, scr, lane);
}

__device__ __forceinline__ void tile_load(float (&r)[32], const float* W, int ldw, int lane) {
#pragma unroll
    for (int i = 0; i < 32; ++i) { const int kk = 2 * i + (lane >> 5); r[i] = W[(size_t)kk * ldw + (lane & 31)]; }
}
__device__ __forceinline__ void tile_store8(const float (&r)[32], unsigned char* dst, int ldd, float sc, LAS float* scr, int lane) {
#pragma unroll
    for (int i = 0; i < 32; ++i) { const int kk = 2 * i + (lane >> 5); scr[kk * 33 + (lane & 31)] = r[i]; }
    LDS_WAIT(); asm volatile("" ::: "memory");
    const int c = lane & 7;
#pragma unroll
    for (int j = 0; j < 4; ++j) { const int n = (lane >> 3) + 8 * j; const LAS float* s = scr + (8 * c) * 33 + n;
        u32x2 o; o.x = pk4_fp8(s[0 * 33] * sc, s[1 * 33] * sc, s[2 * 33] * sc, s[3 * 33] * sc); o.y = pk4_fp8(s[4 * 33] * sc, s[5 * 33] * sc, s[6 * 33] * sc, s[7 * 33] * sc);
        *(u32x2*)(dst + (size_t)n * ldd + 8 * c) = o; }
    LDS_WAIT(); asm volatile("" ::: "memory");
}
__device__ __forceinline__ void phase_pre(const Args& a, Frame& F) {
    unsigned char* ws = F.ws;
    LAS float* scr = (LAS float*)(F.lds + F.wave * 16384);
    const int gw = F.bid * 8 + F.wave, NGW = F.G * 8;
    {
        constexpr int I_EI = 16 * (EVSRC / 32), I_SQ = 16 * 32, I_OI = 16 * (ODN / 32);
        constexpr int NIT = 2 * (I_EI + I_SQ + I_OI + I_SQ);
        for (int it = gw; it < NIT; it += NGW) {
            int r = it; const int i = r & 1; r >>= 1;
            if (r < I_EI) { const int nblk = EVSRC / 32, kb = r / nblk, nb = r % nblk; const int n0 = nb * 32;
                if (n0 != 1536) { const int drow = n0 < 1536 ? n0 : n0 - 32;
                    transpose_tile(a.in[F.z + I_EVWIN] + (size_t)i * D * EVSRC + (size_t)(kb * 64) * EVSRC + n0, EVSRC, (bf16_t*)(ws + WS_WEVIN) + (size_t)i * EVNP * D + (size_t)drow * D + kb * 64, D, scr, F.lane); }
                continue; } r -= I_EI;
            if (r < I_SQ) { transpose_item(a.in[F.z + I_EVWOUT] + (size_t)i * D * D, D, D, (bf16_t*)(ws + WS_WEVOUT) + (size_t)i * D * D, scr, r, F.lane); continue; } r -= I_SQ;
            if (r < I_OI) { const int nblk = ODN / 32, kb = r / nblk, nb = r % nblk; const int n0 = nb * 32;
                const int drow = n0 < 1024 ? n0 : (n0 < 2048 ? 1024 + ((n0 - 1024) >> 7) * 256 + ((n0 - 1024) & 127) : 1024 + ((n0 - 2048) >> 7) * 256 + 128 + ((n0 - 2048) & 127));
                transpose_tile(a.in[F.z + I_ODWIN] + (size_t)i * D * ODN + (size_t)(kb * 64) * ODN + n0, ODN, (bf16_t*)(ws + WS_WODIN) + (size_t)i * ODN * D + (size_t)drow * D + kb * 64, D, scr, F.lane);
                continue; } r -= I_OI;
            { const int kb = r >> 5, nb = r & 31; float tr_[32];
              tile_load(tr_, a.in[F.z + I_ODWOUT] + (size_t)i * D * D + (size_t)(kb * 64) * D + nb * 32, D, F.lane);
              tile_store8(tr_, ws + WS_WODOUT + (size_t)i * D * D + (size_t)(nb * 32) * D + kb * 64, D, SC_WO, scr, F.lane); }
        }
#pragma unroll 2
        for (int idx = F.bid * 512 + F.tid; idx < 2 * 512 * D; idx += F.G * 512) {
            const int k = idx & 1023, n = (idx >> 10) & 511, i = idx >> 19; const int dir = n >> 8, nn = n & 255;
            const float* wr = a.in[F.z + I_EVWIN] + ((size_t)i * D + k) * EVSRC + 1536 + 16 * dir; const float* wa = a.in[F.z + (dir ? I_WAB : I_WAF)] + (size_t)i * 16 * 256 + nn;
            float sacc = 0.f;
#pragma unroll
            for (int r = 0; r < 16; ++r) sacc += wr[r] * wa[r * 256];
            ((bf16_t*)(ws + WS_WEVIN))[(size_t)i * EVNP * D + (size_t)(3072 + n) * D + k] = (bf16_t)f2bf(sacc);
        }
    }
    {
        bf16_t* RW = (bf16_t*)(ws + WS_RW);
        for (int idx = F.bid * 512 + F.tid; idx < DEPTH * 48 * D; idx += F.G * 512) {
            const int k = idx & 1023, n = (idx >> 10) % 48, l = idx / (48 * 1024);
            float v = 0.f;
            if (n < 4) v = a.in[F.z + I_RTWG][((size_t)l * D + k) * 4 + n];
            else if (n < 36) v = a.in[F.z + I_RTWE][((size_t)l * D + k) * 32 + (n - 4)];
            RW[idx] = (bf16_t)f2bf(v);
        }
    }
    __syncthreads();
    {
        LAS float* sc = (LAS float*)F.lds;
        float* MOD = (float*)(ws + WS_MOD);
        for (int unit = F.bid; unit < DEPTH * 6144 / 128; unit += F.G) {
            for (int idx = F.tid; idx < 33 * D; idx += 512) { const int r = idx >> 10, k = idx & 1023; const float cv = r < NB ? a.in[F.z + I_C][r * D + k] : a.in[F.z + I_CCTX][k]; sc[idx] = silu_f(cv); }
            __syncthreads();
            const int col = F.tid & 127, ks = F.tid >> 7; const int gc = unit * 128 + col, l = gc / 6144, n = gc % 6144;
            const float* wp = a.in[F.z + I_MODW] + ((size_t)l * D + ks * 256) * 6144 + n;
            f32x2 acc2[33];
#pragma unroll
            for (int r = 0; r < 33; ++r) acc2[r] = (f32x2){0.f, 0.f};
            f32x2 wa01 = {wp[0], wp[(size_t)1 * 6144]}, wa23 = {wp[(size_t)2 * 6144], wp[(size_t)3 * 6144]}, wb01, wb23;
            for (int k = 0; k < 256; k += 8) {
                wb01 = (f32x2){wp[(size_t)(k + 4) * 6144], wp[(size_t)(k + 5) * 6144]}; wb23 = (f32x2){wp[(size_t)(k + 6) * 6144], wp[(size_t)(k + 7) * 6144]};
                __builtin_amdgcn_sched_barrier(0);
#pragma unroll
                for (int r = 0; r < 33; ++r) { const f32x4 s = *(const LAS f32x4*)(sc + r * D + ks * 256 + k);
                    acc2[r] = __builtin_elementwise_fma((f32x2){s[0], s[1]}, wa01, acc2[r]); acc2[r] = __builtin_elementwise_fma((f32x2){s[2], s[3]}, wa23, acc2[r]); }
                __builtin_amdgcn_sched_barrier(0);
                { const int kn = k + 8 < 256 ? k + 8 : k;
                  wa01 = (f32x2){wp[(size_t)(kn + 0) * 6144], wp[(size_t)(kn + 1) * 6144]}; wa23 = (f32x2){wp[(size_t)(kn + 2) * 6144], wp[(size_t)(kn + 3) * 6144]}; }
                __builtin_amdgcn_sched_barrier(0);
#pragma unroll
                for (int r = 0; r < 33; ++r) { const f32x4 s = *(const LAS f32x4*)(sc + r * D + ks * 256 + k + 4);
                    acc2[r] = __builtin_elementwise_fma((f32x2){s[0], s[1]}, wb01, acc2[r]); acc2[r] = __builtin_elementwise_fma((f32x2){s[2], s[3]}, wb23, acc2[r]); }
                __builtin_amdgcn_sched_barrier(0);
            }
            float acc[33];
#pragma unroll
            for (int r = 0; r < 33; ++r) acc[r] = acc2[r][0] + acc2[r][1];
            __syncthreads();
            LAS float* red = (LAS float*)F.lds;
#pragma unroll
            for (int r = 0; r < 33; ++r) red[(ks * 33 + r) * 128 + col] = acc[r];
            __syncthreads();
            for (int r = ks; r < 33; r += 4) {
                const float s = red[(0 * 33 + r) * 128 + col] + red[(1 * 33 + r) * 128 + col] + red[(2 * 33 + r) * 128 + col] + red[(3 * 33 + r) * 128 + col];
                MOD[((size_t)l * 33 + r) * 6144 + n] = s + a.in[F.z + I_MODB][l * 6144 + n];
            }
            __syncthreads();
        }
    }
    {
        LAS float* zf = (LAS float*)F.lds;
        LAS float* h1 = zf + 32 * 36;
        LAS float* h2 = h1 + 32 * 64;
        for (int it = F.G - 1 - F.bid; it < 2 * 72; it += F.G) {
            const int i = it / 72, r = it % 72; const int sel = r < 64 ? 0 : 1; const int L = sel ? LC : SEQ; const int t0 = (sel ? (r - 64) : r) * 32;
            for (int idx = F.tid; idx < 32 * 33; idx += 512) {
                const int tt = idx / 33, f = idx % 33; const int t = t0 + tt; float v;
                if (f == 0) v = (float)t / (float)(L - 1);
                else { const int k = (f - 1) & 15; const float band = 1e-4f + (float)k * ((15.0f - 1e-4f) / 15.0f);
                    const float cst = (float)(2.0 * 3.14159265358979323846 / (double)L); const float ang = (cst * (float)t) * band;
                    v = (f <= 16) ? (float)cos((double)ang) : (float)sin((double)ang); }
                zf[tt * 36 + f] = v;
            }
            __syncthreads();
            for (int idx = F.tid; idx < 32 * 64; idx += 512) { const int tt = idx >> 6, j = idx & 63; float s = a.in[F.z + I_HYB1][i * 64 + j];
                for (int f = 0; f < 33; ++f) s += zf[tt * 36 + f] * a.in[F.z + I_HYW1][((size_t)i * 33 + f) * 64 + j];
                h1[idx] = sinf(a.in[F.z + I_HYF1][i * 64 + j] * s); }
            __syncthreads();
            for (int idx = F.tid; idx < 32 * 64; idx += 512) { const int tt = idx >> 6, j = idx & 63; float s = a.in[F.z + I_HYB2][i * 64 + j];
                for (int k = 0; k < 64; ++k) s += h1[tt * 64 + k] * a.in[F.z + I_HYW2][((size_t)i * 64 + k) * 64 + j];
                h2[idx] = sinf(a.in[F.z + I_HYF2][i * 64 + j] * s); }
            __syncthreads();
            {
                const int c = F.tid;
                const float mind = logf(1e-2f) / 1.5f, maxd = logf(1e-2f) / 0.3f;
                const float delta = fabsf(mind + (float)c * ((maxd - mind) / 511.0f));
                float f0 = 0.f;
                for (int hf = 0; hf < 2; ++hf) {
                    float w3[64];
#pragma unroll
                    for (int k = 0; k < 64; ++k) w3[k] = a.in[F.z + I_HYW3][((size_t)i * 64 + k) * 1024 + hf * 512 + c];
                    for (int tt = 0; tt < 32; ++tt) {
                        const int t = t0 + tt; float s = 0.f;
#pragma unroll
                        for (int k = 0; k < 64; k += 4) { const f32x4 hv = *(const LAS f32x4*)(h2 + tt * 64 + k); s += hv[0] * w3[k] + hv[1] * w3[k + 1] + hv[2] * w3[k + 2] + hv[3] * w3[k + 3]; }
                        const float tl = (float)t / (float)(L - 1);
                        s *= expf(-tl * delta);
                        bf16_t* kr = (bf16_t*)(ws + WS_KR) + (size_t)i * (9 * MiB / 4) + (sel ? (size_t)(4 * MiB / 2) : 0) + (size_t)c * (sel ? 512 : 4096);
                        if (hf == 0) { if (t == 0) f0 = s; else kr[L - 1 - t] = (bf16_t)f2bf(s); }
                        else { if (t == 0) kr[L - 1] = (bf16_t)f2bf(f0 + s); else kr[L - 1 + t] = (bf16_t)f2bf(s); }
                    }
                }
            }
            __syncthreads();
        }
    }
}

__device__ __forceinline__ void phase_expconv(const Args& a, Frame& F, int l) {
    LAS float* scr = (LAS float*)(F.lds + F.wave * 16384);
    const int gw = F.bid * 8 + F.wave, NGW = F.G * 8;
    unsigned char* W13 = F.ws + WS_EXP; unsigned char* W2T = F.ws + WS_W2T;
    constexpr int PER_E = 3 * 256; constexpr int NIT = NEXP * PER_E;
    const float* w1b = a.in[F.z + I_EXW1] + (size_t)l * NEXP * D * DE; const float* w3b = a.in[F.z + I_EXW3] + (size_t)l * NEXP * D * DE; const float* w2b = a.in[F.z + I_EXW2] + (size_t)l * NEXP * DE * D;
    auto decode = [&](int it, const float*& src, int& ldw, unsigned char*& dst, int& ldd, float& sc) {
        const int e = it / PER_E; int r = it % PER_E;
        if (r < 512) { const int which = r >> 8; r &= 255; const int kb = r >> 4, nb = r & 15;
            const int n0 = nb * 32; const int drow = (n0 >> 7) * 256 + which * 128 + (n0 & 127);
            src = (which ? w3b : w1b) + (size_t)e * D * DE + (size_t)(kb * 64) * DE + n0; ldw = DE; dst = W13 + ((size_t)e * 1024 + drow) * 1024 + kb * 64; ldd = 1024; sc = SC_W13;
        } else { r -= 512; const int kb = r >> 5, nb = r & 31;
            src = w2b + (size_t)e * DE * D + (size_t)(kb * 64) * D + nb * 32; ldw = D; dst = W2T + (size_t)e * D * DE + (size_t)(nb * 32) * DE + kb * 64; ldd = DE; sc = SC_W2; }
    };
    unsigned* qctr = (unsigned*)(F.ws + WS_CTL) + CW_XQ + 64 * l;
    (void)gw; (void)NGW;
    for (;;) {
        int base = 0;
        if (F.lane == 0) base = (int)__hip_atomic_fetch_add(qctr, 16u, __ATOMIC_RELAXED, __HIP_MEMORY_SCOPE_AGENT);
        base = __builtin_amdgcn_readfirstlane(base);
        if (base >= NIT) break;
        const int lim = (base + 16 < NIT) ? base + 16 : NIT;
        int it = base;
        const float* src; int ldw; unsigned char* dst; int ldd; float sc;
        decode(it, src, ldw, dst, ldd, sc);
        float r0[32], r1[32];
        tile_load(r0, src, ldw, F.lane);
        for (;;) {
            const int it1 = it + 1; const bool h1 = it1 < lim; unsigned char* dst1 = dst; int ldd1 = ldd; float sc1 = sc;
            if (h1) { const float* s1; int lw1; decode(it1, s1, lw1, dst1, ldd1, sc1); tile_load(r1, s1, lw1, F.lane); }
            tile_store8(r0, dst, ldd, sc, scr, F.lane);
            if (!h1) break;
            const int it2 = it1 + 1; const bool h2 = it2 < lim;
            if (h2) { const float* s2; int lw2; decode(it2, s2, lw2, dst, ldd, sc); tile_load(r0, s2, lw2, F.lane); }
            tile_store8(r1, dst1, ldd1, sc1, scr, F.lane);
            if (!h2) break;
            it = it2;
        }
    }
}

__device__ __forceinline__ void build_tiles(Frame& F, const unsigned* cntg, bool table) {
    __syncthreads();
    if (F.tid < 64) {
        const int e = F.tid;
        const unsigned c = e < NEXP ? __hip_atomic_load(cntg + e, __ATOMIC_RELAXED, __HIP_MEMORY_SCOPE_AGENT) : 0u;
        const unsigned nt = (c + 255u) >> 8;
        int inc = (int)nt;
        inc += __builtin_amdgcn_update_dpp(0, inc, 0x111, 0xf, 0xf, false);
        inc += __builtin_amdgcn_update_dpp(0, inc, 0x112, 0xf, 0xf, false);
        inc += __builtin_amdgcn_update_dpp(0, inc, 0x114, 0xf, 0xf, false);
        inc += __builtin_amdgcn_update_dpp(0, inc, 0x118, 0xf, 0xf, false);
        inc += __builtin_amdgcn_update_dpp(0, inc, 0x142, 0xa, 0xf, false);
        inc += __builtin_amdgcn_update_dpp(0, inc, 0x143, 0xc, 0xf, false);
        const unsigned t1 = (unsigned)inc, t0 = t1 - nt;
        if (e < NEXP) { F.MISC[MW_CNT + e] = c; F.MISC[MW_TSTART + e] = t0; }
        if (e == NEXP - 1) F.MISC[MW_TSTART + NEXP] = t1;
        if (table && e < NEXP) for (unsigned t = t0; t < t1; ++t) F.MISC[MW_TILE + t] = (unsigned)e;
    }
    __syncthreads();
}

__device__ __forceinline__ void phase_norm1(const Args& a, Frame& F, int l) {
    unsigned char* ws = F.ws;
    const bool comb = l > 0, fin = (l == DEPTH);
    const float* MOD = (const float*)(ws + WS_MOD);
    if (comb) build_tiles(F, (const unsigned*)(ws + WS_CTL) + CW_CNT + (l - 1) * 32, false);
    const int rlo = (l >= 3) ? RC : 0;
    const int nrows = RT - rlo; const int NGW = F.G * 8, gw = F.bid * 8 + F.wave;
    const int per = (nrows + NGW - 1) / NGW; const int r0 = rlo + gw * per; const int r1 = (r0 + per < RT) ? r0 + per : RT;
    const u32x4* REC = (const u32x4*)(ws + WS_REC); const unsigned char* Y = ws + WS_Y;
    bf16_t* ACT = (bf16_t*)(ws + WS_ACT); bf16_t* H16 = (bf16_t*)(ws + WS_H16);
    const float* gvec = fin ? a.in[F.z + I_NFIN] : a.in[F.z + I_NMIX] + l * D;
    int curb = -1; f32x4 cA[4], cB[4], cG[4];
    u32x4 prec[2]; u32x2 ph[2][4]; f32x4 pf[2][4];
    auto request = [&](const int rw0, const int rw1) __attribute__((always_inline)) {
        if (comb) { prec[0] = REC[rw0]; prec[1] = REC[rw1]; }
        if (l > 0) { const u32x2* h0 = (const u32x2*)(H16 + (size_t)rw0 * D); const u32x2* h1 = (const u32x2*)(H16 + (size_t)rw1 * D);
#pragma unroll
            for (int j = 0; j < 4; ++j) { ph[0][j] = h0[F.lane + 64 * j]; ph[1][j] = h1[F.lane + 64 * j]; } }
        else {
            const float* s0 = rw0 < RC ? a.in[F.z + I_CTX] + (size_t)rw0 * D : a.in[F.z + I_X] + (size_t)(rw0 - RC) * D;
            const float* s1 = rw1 < RC ? a.in[F.z + I_CTX] + (size_t)rw1 * D : a.in[F.z + I_X] + (size_t)(rw1 - RC) * D;
#pragma unroll
            for (int j = 0; j < 4; ++j) { pf[0][j] = *((const f32x4*)s0 + F.lane + 64 * j); pf[1][j] = *((const f32x4*)s1 + F.lane + 64 * j); } }
    };
    { const int q0 = r0 < RT ? r0 : RT - 1, q1 = r0 + 1 < RT ? r0 + 1 : RT - 1; request(q0, q1); }
    for (int row = r0; row < r1;) {
        const int b = row < RC ? NB : ((row - RC) >> 11);
        if (b != curb) { curb = b;
#pragma unroll
            for (int j = 0; j < 4; ++j) { const int col = (F.lane + 64 * j) * 4; const f32x4 g = *(const f32x4*)(gvec + col);
                if (!fin) { const float* m = MOD + ((size_t)l * 33 + b) * 6144; const f32x4 sh = *(const f32x4*)(m + col), scv = *(const f32x4*)(m + D + col); cA[j] = g * (scv + 1.0f); cB[j] = sh; }
                else { cA[j] = g; cB[j] = (f32x4){0.f, 0.f, 0.f, 0.f}; }
                if (comb) cG[j] = *(const f32x4*)(MOD + ((size_t)(l - 1) * 33 + b) * 6144 + 5 * D + col); else cG[j] = (f32x4){0.f, 0.f, 0.f, 0.f}; }
        }
        const int rowB = row + 1; const bool two = rowB < r1 && (rowB < RC ? NB : ((rowB - RC) >> 11)) == b;
        const int rws[2] = {row, two ? rowB : row};
        f32x4 v[2][4];
        u32x4 rec[2];
        asm volatile("" : "+v"(prec[0]), "+v"(prec[1]));
#pragma unroll
        for (int j = 0; j < 4; ++j) asm volatile("" : "+v"(ph[0][j]), "+v"(ph[1][j]));
        if (comb) { rec[0] = prec[0]; rec[1] = two ? prec[1] : prec[0]; }
#pragma unroll
        for (int rr = 0; rr < 2; ++rr) {
            if (l == 0) {
#pragma unroll
                for (int j = 0; j < 4; ++j) { asm volatile("" : "+v"(pf[0][j]), "+v"(pf[1][j])); v[rr][j] = (rr == 1 && two) ? pf[1][j] : pf[0][j]; }
            } else {
#pragma unroll
                for (int j = 0; j < 4; ++j) { const u32x2 w = (rr == 1 && two) ? ph[1][j] : ph[0][j]; v[rr][j] = (f32x4){bflo(w.x), bfhi(w.x), bflo(w.y), bfhi(w.y)}; }
            }
        }
        { const int nrow = row + (two ? 2 : 1); const int q0 = nrow < RT ? nrow : RT - 1, q1 = nrow + 1 < RT ? nrow + 1 : RT - 1; request(q0, q1); }
        if (comb) {
            unsigned ya[2][4], yb[2][4]; float g0[2], g1[2];
#pragma unroll
            for (int rr = 0; rr < 2; ++rr) {
                const unsigned rx = rec[rr].x, ry = rec[rr].y, gz_ = rec[rr].z, gw_ = rec[rr].w;
                const int e0 = rx >> 20, p0 = rx & 0xfffff, e1 = ry >> 20, p1 = ry & 0xfffff;
                g0[rr] = __builtin_bit_cast(float, gz_) * (1.0f / SC_Y); g1[rr] = __builtin_bit_cast(float, gw_) * (1.0f / SC_Y);
                const size_t s0 = (size_t)F.MISC[MW_TSTART + e0] * 256 + p0, s1 = (size_t)F.MISC[MW_TSTART + e1] * 256 + p1;
                const unsigned* y0 = (const unsigned*)(Y + s0 * D); const unsigned* y1 = (const unsigned*)(Y + s1 * D);
#pragma unroll
                for (int j = 0; j < 4; ++j) { ya[rr][j] = y0[F.lane + 64 * j]; yb[rr][j] = y1[F.lane + 64 * j]; }
            }
#pragma unroll
            for (int rr = 0; rr < 2; ++rr) {
#pragma unroll
                for (int j = 0; j < 4; ++j) { const f32x4 f = up4_fp8(ya[rr][j]) * g0[rr] + up4_fp8(yb[rr][j]) * g1[rr];
                    v[rr][j] = v[rr][j] + cG[j] * f; }
                if (!fin && (rr == 0 || two)) { u32x2* hw = (u32x2*)(H16 + (size_t)rws[rr] * D);
#pragma unroll
                    for (int j = 0; j < 4; ++j) { u32x2 w; w.x = pk2(v[rr][j][0], v[rr][j][1]); w.y = pk2(v[rr][j][2], v[rr][j][3]); hw[F.lane + 64 * j] = w; }
                }
            }
        }
#pragma unroll
        for (int rr = 0; rr < 2; ++rr) {
            float ss = 0.f;
#pragma unroll
            for (int j = 0; j < 4; ++j) ss += (v[rr][j][0] * v[rr][j][0] + v[rr][j][1] * v[rr][j][1]) + (v[rr][j][2] * v[rr][j][2] + v[rr][j][3] * v[rr][j][3]);
            const float rstd = __builtin_amdgcn_rsqf(wave_sum(ss) * (1.0f / D) + EPS);
            if (rr == 0 || two) {
                if (fin) { float* orow = a.out + (size_t)(rws[rr] - RC) * D;
#pragma unroll
                    for (int j = 0; j < 4; ++j) *((f32x4*)orow + F.lane + 64 * j) = v[rr][j] * rstd * cA[j];
                } else {
                    u32x2* o = (u32x2*)(ACT + (size_t)rws[rr] * D);
#pragma unroll
                    for (int j = 0; j < 4; ++j) { const f32x4 u = v[rr][j] * rstd * cA[j] + cB[j]; u32x2 w; w.x = pk2(u[0], u[1]); w.y = pk2(u[2], u[3]); o[F.lane + 64 * j] = w; }
                }
            }
        }
        row += two ? 2 : 1;
    }
}

__device__ __forceinline__ void phase_norm2(const Args& a, Frame& F, int l) {
    unsigned char* ws = F.ws;
    const float* MOD = (const float*)(ws + WS_MOD);
    constexpr int TP = 1032;
    LAS bf16_t* tile = (LAS bf16_t*)F.lds;
    LAS float* part = (LAS float*)(F.lds + 66560);
    LAS float* lgt = (LAS float*)(F.lds + 66560 + 49152);
    LAS unsigned* recs = (LAS unsigned*)(F.lds + 66560 + 49152 + 6144);
    constexpr int NREC = 512;
    volatile LAS unsigned* hist = F.MISC + MW_HIST;
    unsigned* cntg = (unsigned*)(ws + WS_CTL) + CW_CNT + l * 32;
    const int rlo = (l >= 3) ? RC : 0; const int ngroups = (RT - rlo) / 32;
    const int per = (ngroups + F.G - 1) / F.G; const int g0 = F.bid * per; const int g1 = (g0 + per < ngroups) ? g0 + per : ngroups;
    unsigned char* ACT8 = ws + WS_ACT; const bf16_t* H16 = (const bf16_t*)(ws + WS_H16);
    const bf16_t* RW = (const bf16_t*)(ws + WS_RW) + (size_t)l * 48 * D;
    int* TOK = (int*)(ws + WS_TOK); u32x4* REC = (u32x4*)(ws + WS_REC);
    bf16x8 Bf[4][3];
    { const int n = F.lane & 15, kq = F.lane >> 4;
#pragma unroll
      for (int ks = 0; ks < 4; ++ks)
#pragma unroll
          for (int nb = 0; nb < 3; ++nb) Bf[ks][nb] = *(const bf16x8*)(RW + (size_t)(nb * 16 + n) * D + F.wave * 128 + ks * 32 + kq * 8); }
    if (F.tid < 64) hist[F.tid] = 0u;
    LAS float* rbias = (LAS float*)(F.lds + 66560 + 49152 + 6144 + NREC * 16);
    if (F.tid < 4) rbias[F.tid] = a.in[F.z + I_RTBG][l * 4 + F.tid]; else if (F.tid < 36) rbias[F.tid] = a.in[F.z + I_RTBE][l * 32 + F.tid - 4];
    int nrec = 0; int curb = -1; f32x4 cA[4], cB[4];
    __syncthreads();
    auto flush = [&]() {
        __syncthreads();
        if (F.tid < NEXP) { const unsigned h = hist[F.tid]; hist[32 + F.tid] = h ? __hip_atomic_fetch_add(cntg + F.tid, h, __ATOMIC_RELAXED, __HIP_MEMORY_SCOPE_AGENT) : 0u; hist[F.tid] = 0u; }
        __syncthreads();
        if (F.tid < nrec) {
            const unsigned tok = recs[F.tid * 4], ee = recs[F.tid * 4 + 1]; const unsigned e0 = ee & 255u, e1 = ee >> 8;
            const unsigned p0 = hist[32 + e0] + __hip_atomic_fetch_add((LAS unsigned*)&hist[e0], 1u, __ATOMIC_RELAXED, __HIP_MEMORY_SCOPE_WORKGROUP);
            const unsigned p1 = hist[32 + e1] + __hip_atomic_fetch_add((LAS unsigned*)&hist[e1], 1u, __ATOMIC_RELAXED, __HIP_MEMORY_SCOPE_WORKGROUP);
            TOK[(size_t)e0 * RT + p0] = (int)tok; TOK[(size_t)e1 * RT + p1] = (int)tok;
            u32x4 r; r.x = (e0 << 20) | p0; r.y = (e1 << 20) | p1; r.z = recs[F.tid * 4 + 2]; r.w = recs[F.tid * 4 + 3]; REC[tok] = r;
        }
        __syncthreads();
        if (F.tid < NEXP) hist[F.tid] = 0u;
        nrec = 0;
        __syncthreads();
    };
    u32x2 raw[4][4];
    if (g0 < g1) {
#pragma unroll
        for (int q = 0; q < 4; ++q) { const u32x2* hr = (const u32x2*)(H16 + (size_t)(rlo + g0 * 32 + F.wave * 4 + q) * D);
#pragma unroll
            for (int j = 0; j < 4; ++j) raw[q][j] = hr[F.lane + 64 * j]; }
    }
    for (int g = g0; g < g1; ++g) {
        const int rowg = rlo + g * 32; const int b = rowg < RC ? NB : ((rowg - RC) >> 11);
        if (b != curb) { curb = b; const float* m = MOD + ((size_t)l * 33 + b) * 6144;
#pragma unroll
            for (int j = 0; j < 4; ++j) { const int col = (F.lane + 64 * j) * 4; const f32x4 g = *(const f32x4*)(a.in[F.z + I_NFFN] + l * D + col);
                cA[j] = g * (*(const f32x4*)(m + 4 * D + col) + 1.0f); cB[j] = *(const f32x4*)(m + 3 * D + col); } }
        f32x4 v[4][4];
#pragma unroll
        for (int q = 0; q < 4; ++q)
#pragma unroll
            for (int j = 0; j < 4; ++j) { const u32x2 w = raw[q][j]; v[q][j] = (f32x4){bflo(w.x), bfhi(w.x), bflo(w.y), bfhi(w.y)}; }
        if (g + 1 < g1) {
#pragma unroll
            for (int q = 0; q < 4; ++q) { const u32x2* hr = (const u32x2*)(H16 + (size_t)(rowg + 32 + F.wave * 4 + q) * D);
#pragma unroll
                for (int j = 0; j < 4; ++j) raw[q][j] = hr[F.lane + 64 * j]; }
        }
#pragma unroll
        for (int q = 0; q < 4; ++q) { const int rl = F.wave * 4 + q; const int row = rowg + rl; float ss = 0.f;
#pragma unroll
            for (int j = 0; j < 4; ++j) ss += (v[q][j][0] * v[q][j][0] + v[q][j][1] * v[q][j][1]) + (v[q][j][2] * v[q][j][2] + v[q][j][3] * v[q][j][3]);
            const float rstd = __builtin_amdgcn_rsqf(wave_sum(ss) * (1.0f / D) + EPS);
            unsigned* o8 = (unsigned*)(ACT8 + (size_t)row * D);
#pragma unroll
            for (int j = 0; j < 4; ++j) { const f32x4 u = v[q][j] * rstd * cA[j] + cB[j]; u32x2 w; w.x = pk2(u[0], u[1]); w.y = pk2(u[2], u[3]);
                o8[F.lane + 64 * j] = pk4_fp8(u[0] * SC_V, u[1] * SC_V, u[2] * SC_V, u[3] * SC_V);
                *(LAS u32x2*)(tile + rl * TP + (F.lane + 64 * j) * 4) = w; } }
        __syncthreads();
        {
            const int rr = F.lane & 15, kq = F.lane >> 4;
#pragma unroll
            for (int rg = 0; rg < 2; ++rg) {
                f32x4 c3[3] = {(f32x4){0.f, 0.f, 0.f, 0.f}, (f32x4){0.f, 0.f, 0.f, 0.f}, (f32x4){0.f, 0.f, 0.f, 0.f}};
#pragma unroll
                for (int ks = 0; ks < 4; ++ks) { const bf16x8 af = *(const LAS bf16x8*)(tile + (rg * 16 + rr) * TP + F.wave * 128 + ks * 32 + kq * 8);
#pragma unroll
                    for (int nb = 0; nb < 3; ++nb) c3[nb] = __builtin_amdgcn_mfma_f32_16x16x32_bf16(af, Bf[ks][nb], c3[nb], 0, 0, 0); }
#pragma unroll
                for (int nb = 0; nb < 3; ++nb)
#pragma unroll
                    for (int j = 0; j < 4; ++j) part[(F.wave * 32 + rg * 16 + kq * 4 + j) * 48 + nb * 16 + rr] = c3[nb][j];
            }
        }
        __syncthreads();
        for (int idx = F.tid; idx < 32 * 48; idx += 512) { float s = 0.f;
#pragma unroll
            for (int w = 0; w < 8; ++w) s += part[w * 32 * 48 + idx];
            lgt[idx] = s; }
        __syncthreads();
        if (F.tid < 32) {
            const int row = rowg + F.tid; const LAS float* lg = lgt + F.tid * 48;
            float gl[4]; float gm = -3.0e38f; int grp = 0;
#pragma unroll
            for (int j = 0; j < 4; ++j) { gl[j] = lg[j] + rbias[j]; if (gl[j] > gm) { gm = gl[j]; grp = j; } }
            float gs = 0.f;
#pragma unroll
            for (int j = 0; j < 4; ++j) gs += __expf(gl[j] - gm);
            const float pg = __builtin_amdgcn_rcpf(gs);
            float el[8]; float m0 = -3.0e38f, m1 = -3.0e38f; int i0 = 0, i1 = 0;
#pragma unroll
            for (int j = 0; j < 8; ++j) { el[j] = lg[4 + grp * 8 + j] + rbias[4 + grp * 8 + j]; }
#pragma unroll
            for (int j = 0; j < 8; ++j) if (el[j] > m0) { m0 = el[j]; i0 = j; }
#pragma unroll
            for (int j = 0; j < 8; ++j) if (j != i0 && el[j] > m1) { m1 = el[j]; i1 = j; }
            const float x1 = __expf(m1 - m0); const float rx = __builtin_amdgcn_rcpf(1.0f + x1); float w0 = pg * rx, w1 = pg * x1 * rx;
            const unsigned e0 = (unsigned)(grp * 8 + i0), e1 = (unsigned)(grp * 8 + i1);
            const int ri = nrec + F.tid;
            recs[ri * 4] = (unsigned)row; recs[ri * 4 + 1] = e0 | (e1 << 8); recs[ri * 4 + 2] = __builtin_bit_cast(unsigned, w0); recs[ri * 4 + 3] = __builtin_bit_cast(unsigned, w1);
            __hip_atomic_fetch_add((LAS unsigned*)&hist[e0], 1u, __ATOMIC_RELAXED, __HIP_MEMORY_SCOPE_WORKGROUP); __hip_atomic_fetch_add((LAS unsigned*)&hist[e1], 1u, __ATOMIC_RELAXED, __HIP_MEMORY_SCOPE_WORKGROUP);
        }
        nrec += 32;
        if (nrec == NREC) flush();
    }
    if (nrec > 0) flush();
}


__device__ __forceinline__ void phase_gla2(const Args& a, Frame& F, int i, bool cm) {
    unsigned char* ws = F.ws;
    const bf16_t* P = (const bf16_t*)(ws + WS_P); const bf16_t* Gd = (const bf16_t*)(ws + WS_G);
    constexpr int RP = 72;
    LAS bf16_t* QD = (LAS bf16_t*)F.lds;
    LAS bf16_t* KD = QD + 64 * RP;
    LAS bf16_t* KRT = KD + 64 * RP;
    LAS bf16_t* VT = KRT + 64 * RP;
    LAS float* ST = (LAS float*)(VT + 128 * RP);
    LAS float* EBL = ST + 512;
    LAS bf16_t* OS = (LAS bf16_t*)(EBL + 64);
    const int tok = F.tid >> 3, dg = F.tid & 7;
    const int dk = F.lane;
    const int dv = F.tid & 127, tg = F.tid >> 7;
    const int l15 = F.lane & 15, kq = F.lane >> 4;
    for (int item = F.bid; item < 2 * NB * 4; item += F.G) {
        const int dir = item >> 7, b = (item >> 2) & 31, h = item & 3;
        unsigned char* O = ws + (dir ? WS_OB : WS_OF);
        f32x4 S[4];
#pragma unroll
        for (int q = 0; q < 4; ++q) S[q] = (f32x4){0.f, 0.f, 0.f, 0.f};
        auto row_of = [&](int ch, int t) -> int {
            if (ch < 4) { const int p = ch * 64 + t; return b * LC + (dir ? (LC - 1 - p) : p); }
            const int j = (ch - 4) * 64 + t; return lat_row(b, dir ? (SEQ - 1 - j) : j, cm); };
        unsigned rq[8], rk[8], rg[8], rv[16];
        const unsigned voA = (unsigned)(h * 64 + dk) * 2u, voG = (unsigned)(dir * 256 + h * 64 + dk) * 2u, voV = (unsigned)(512 + h * 128 + dv) * 2u;
#define GLA_GP(p) ((const __attribute__((address_space(1))) bf16_t*)(p))
#define GLA_LOADS(rA0, dA, rB0, dB) do { \
            _Pragma("unroll") for (int q = 0; q < 8; ++q) { const size_t row = (size_t)((rA0) + q * (dA)); unsigned long long pb = (unsigned long long)P + row * (size_t)(EVN * 2), gb = (unsigned long long)Gd + row * 1024; \
                asm volatile("" : "+s"(pb), "+s"(gb)); \
                rq[q] = *GLA_GP(pb + voA); rk[q] = *GLA_GP(pb + voA + 512); rg[q] = *GLA_GP(gb + voG); } \
            _Pragma("unroll") for (int q = 0; q < 16; ++q) { unsigned long long pb = (unsigned long long)P + (size_t)((rB0) + q * (dB)) * (size_t)(EVN * 2); asm volatile("" : "+s"(pb)); rv[q] = *GLA_GP(pb + voV); } } while (0)
        { const int rA0 = __builtin_amdgcn_readfirstlane(row_of(0, F.wave * 8)), dA = __builtin_amdgcn_readfirstlane(row_of(0, F.wave * 8 + 1)) - rA0;
          const int rB0 = __builtin_amdgcn_readfirstlane(row_of(0, tg * 16)), dB = __builtin_amdgcn_readfirstlane(row_of(0, tg * 16 + 1)) - rB0;
          GLA_LOADS(rA0, dA, rB0, dB); }
        __syncthreads();
        for (int ch = 0; ch < 36; ++ch) {
            float bb[8];
            { float run = 0.f;
#pragma unroll
              for (int q = 0; q < 8; ++q) { run += __builtin_bit_cast(float, rg[q] << 16); bb[q] = run; }
              ST[F.wave * 64 + dk] = run; }
            __syncthreads();
            {
                float pre = 0.f, tot = 0.f;
#pragma unroll
                for (int w = 0; w < 8; ++w) { const float sv = ST[w * 64 + dk]; tot += sv; if (w < F.wave) pre += sv; }
                const float etot = __expf(tot);
                unsigned krp[4];
#pragma unroll
                for (int q = 0; q < 8; ++q) {
                    const float bq = bb[q] + pre; const float e = __expf(bq), en = __builtin_amdgcn_rcpf(e), el = etot * en;
                    const float qv = __builtin_bit_cast(float, rq[q] << 16), kv = __builtin_bit_cast(float, rk[q] << 16);
                    QD[(F.wave * 8 + q) * RP + dk] = (bf16_t)f2bf(qv * 0.125f * e);
                    KD[(F.wave * 8 + q) * RP + dk] = (bf16_t)f2bf(kv * en);
                    const unsigned kb = f2bf(kv * el); if (q & 1) krp[q >> 1] |= kb << 16; else krp[q >> 1] = kb;
                }
                *(LAS u32x4*)(KRT + dk * RP + F.wave * 8) = (u32x4){krp[0], krp[1], krp[2], krp[3]};
                if (F.wave == 0) EBL[dk] = etot;
                u32x4 v0, v1;
                v0.x = (unsigned)rv[0] | ((unsigned)rv[1] << 16); v0.y = (unsigned)rv[2] | ((unsigned)rv[3] << 16); v0.z = (unsigned)rv[4] | ((unsigned)rv[5] << 16); v0.w = (unsigned)rv[6] | ((unsigned)rv[7] << 16);
                v1.x = (unsigned)rv[8] | ((unsigned)rv[9] << 16); v1.y = (unsigned)rv[10] | ((unsigned)rv[11] << 16); v1.z = (unsigned)rv[12] | ((unsigned)rv[13] << 16); v1.w = (unsigned)rv[14] | ((unsigned)rv[15] << 16);
                *(LAS u32x4*)(VT + dv * RP + tg * 16) = v0; *(LAS u32x4*)(VT + dv * RP + tg * 16 + 8) = v1;
            }
            if (ch + 1 < 36) {
                const int rA0 = __builtin_amdgcn_readfirstlane(row_of(ch + 1, F.wave * 8)), dA = __builtin_amdgcn_readfirstlane(row_of(ch + 1, F.wave * 8 + 1)) - rA0;
                const int rB0 = __builtin_amdgcn_readfirstlane(row_of(ch + 1, tg * 16)), dB = __builtin_amdgcn_readfirstlane(row_of(ch + 1, tg * 16 + 1)) - rB0;
                GLA_LOADS(rA0, dA, rB0, dB);
            }
            __syncthreads();
            {
                f32x4 C[4][4];
                {
                    bf16x8 kdf[4][2], qdf[4][2];
#pragma unroll
                    for (int sb = 0; sb < 4; ++sb)
#pragma unroll
                        for (int ks = 0; ks < 2; ++ks) { kdf[sb][ks] = *(const LAS bf16x8*)(KD + (16 * sb + l15) * RP + 32 * ks + 8 * kq); qdf[sb][ks] = *(const LAS bf16x8*)(QD + (16 * sb + l15) * RP + 32 * ks + 8 * kq); }
#pragma unroll
                    for (int sb = 0; sb < 4; ++sb)
#pragma unroll
                        for (int tb = 0; tb < 4; ++tb) {
                            f32x4 c = (f32x4){0.f, 0.f, 0.f, 0.f};
                            if (tb >= sb) {
#pragma unroll
                                for (int ks = 0; ks < 2; ++ks) c = __builtin_amdgcn_mfma_f32_16x16x32_bf16(kdf[sb][ks], qdf[tb][ks], c, 0, 0, 0);
                                if (tb == sb) {
#pragma unroll
                                    for (int rg = 0; rg < 4; ++rg) if (4 * kq + rg > l15) c[rg] = 0.f; }
                            }
                            C[sb][tb] = c;
                        }
                }
                bf16x8 sf[2];
#pragma unroll
                for (int m = 0; m < 2; ++m) { u32x4 w; w.x = pg8::cvt_pk_bf16(S[2 * m][0], S[2 * m][1]); w.y = pg8::cvt_pk_bf16(S[2 * m][2], S[2 * m][3]);
                    w.z = pg8::cvt_pk_bf16(S[2 * m + 1][0], S[2 * m + 1][1]); w.w = pg8::cvt_pk_bf16(S[2 * m + 1][2], S[2 * m + 1][3]); sf[m] = __builtin_bit_cast(bf16x8, w); }
                bf16x8 vtp[2];
#pragma unroll
                for (int m = 0; m < 2; ++m) { const u32x2 lo = *(const LAS u32x2*)(VT + (16 * F.wave + l15) * RP + 32 * m + 4 * kq), hi = *(const LAS u32x2*)(VT + (16 * F.wave + l15) * RP + 32 * m + 16 + 4 * kq);
                    vtp[m] = __builtin_bit_cast(bf16x8, (u32x4){lo.x, lo.y, hi.x, hi.y}); }
#pragma unroll
                for (int tb = 0; tb < 4; ++tb) {
                    f32x4 o = (f32x4){0.f, 0.f, 0.f, 0.f};
#pragma unroll
                    for (int m = 0; m < 2; ++m) if (2 * m <= tb) {
                        const f32x4 lo = C[2 * m][tb], hi = C[2 * m + 1][tb];
                        u32x4 w; w.x = pg8::cvt_pk_bf16(lo[0], lo[1]); w.y = pg8::cvt_pk_bf16(lo[2], lo[3]); w.z = pg8::cvt_pk_bf16(hi[0], hi[1]); w.w = pg8::cvt_pk_bf16(hi[2], hi[3]);
                        o = __builtin_amdgcn_mfma_f32_16x16x32_bf16(vtp[m], __builtin_bit_cast(bf16x8, w), o, 0, 0, 0); }
#pragma unroll
                    for (int m = 0; m < 2; ++m) { const u32x2 lo = *(const LAS u32x2*)(QD + (16 * tb + l15) * RP + 32 * m + 4 * kq), hi = *(const LAS u32x2*)(QD + (16 * tb + l15) * RP + 32 * m + 16 + 4 * kq);
                        o = __builtin_amdgcn_mfma_f32_16x16x32_bf16(sf[m], __builtin_bit_cast(bf16x8, (u32x4){lo.x, lo.y, hi.x, hi.y}), o, 0, 0, 0); }
                    { u32x2 ow; ow.x = pg8::cvt_pk_bf16(o[0], o[1]); ow.y = pg8::cvt_pk_bf16(o[2], o[3]); *(LAS u32x2*)(OS + (16 * tb + l15) * 136 + 16 * F.wave + 4 * kq) = ow; }
                }
#pragma unroll
                for (int q = 0; q < 4; ++q) { const f32x4 sc = *(const LAS f32x4*)(EBL + 16 * q + 4 * kq); S[q] = S[q] * sc; }
#pragma unroll
                for (int m = 0; m < 2; ++m) { const bf16x8 vn = *(const LAS bf16x8*)(VT + (16 * F.wave + l15) * RP + 32 * m + 8 * kq);
#pragma unroll
                    for (int q = 0; q < 4; ++q) S[q] = __builtin_amdgcn_mfma_f32_16x16x32_bf16(*(const LAS bf16x8*)(KRT + (16 * q + l15) * RP + 32 * m + 8 * kq), vn, S[q], 0, 0, 0); }
            }
            __syncthreads();
            {
                unsigned char* op = O + (size_t)row_of(ch, tok) * 512 + h * 128 + dg * 16;
                const u32x4 w0 = *(const LAS u32x4*)(OS + tok * 136 + dg * 16), w1 = *(const LAS u32x4*)(OS + tok * 136 + dg * 16 + 8);
                u32x4 o8;
                o8.x = pk4_fp8(bflo(w0.x) * SC_O, bfhi(w0.x) * SC_O, bflo(w0.y) * SC_O, bfhi(w0.y) * SC_O); o8.y = pk4_fp8(bflo(w0.z) * SC_O, bfhi(w0.z) * SC_O, bflo(w0.w) * SC_O, bfhi(w0.w) * SC_O);
                o8.z = pk4_fp8(bflo(w1.x) * SC_O, bfhi(w1.x) * SC_O, bflo(w1.y) * SC_O, bfhi(w1.y) * SC_O); o8.w = pk4_fp8(bflo(w1.z) * SC_O, bfhi(w1.z) * SC_O, bflo(w1.w) * SC_O, bfhi(w1.w) * SC_O);
                *(u32x4*)op = o8;
            }
#pragma unroll
            for (int q = 0; q < 8; ++q) asm volatile("" : "+v"(rq[q]), "+v"(rk[q]), "+v"(rg[q]));
#pragma unroll
            for (int q = 0; q < 16; ++q) asm volatile("" : "+v"(rv[q]));
        }
    }
    __syncthreads();
#undef GLA_LOADS
#undef GLA_GP
}


constexpr int HP_L = SEQ + 64, HP_C = LC + 64;
constexpr size_t HC_L = (size_t)NB * HP_L + 128, HC_C = (size_t)NB * HP_C + 128;
constexpr size_t HY_CTX0 = (size_t)HYW * HC_L;
static_assert((HY_CTX0 + (size_t)HYW * HC_C) * 2 <= 80 * MiB, "padded hyena layout fits its regions");
__device__ __forceinline__ size_t hy_row(bool lat, int c, int b) { return lat ? (size_t)c * HC_L + (size_t)b * HP_L : HY_CTX0 + (size_t)c * HC_C + (size_t)b * HP_C; }
__device__ __forceinline__ void phase_hypre2(const Args& a, Frame& F, int i, bool cm) {
    unsigned char* ws = F.ws;
    const bf16_t* P = (const bf16_t*)(ws + WS_P);
    bf16_t* WT = (bf16_t*)(ws + WS_WT); bf16_t* XT = (bf16_t*)(ws + WS_X0T);
    constexpr int TP = 520;
    LAS bf16_t* tw = (LAS bf16_t*)F.lds; LAS bf16_t* tx = tw + 64 * TP;
    const float* cw = a.in[F.z + I_HYCW] + (size_t)i * 3 * 1536; const float* cb = a.in[F.z + I_HYCB] + (size_t)i * 1536;
    const int c0 = F.lane * 8;
    constexpr int NU_L = NB * (SEQ / 64), NU_C = NB * (LC / 64);
    u32x4 pre[10];
    auto load_part0 = [&](const int un, u32x4 (&dst)[10]) __attribute__((always_inline)) {
        const bool lat_ = un < NU_L; const int L_ = lat_ ? SEQ : LC; const int uu_ = lat_ ? un : un - NU_L; const int tpb_ = L_ / 64, b_ = uu_ / tpb_, p0_ = (uu_ % tpb_) * 64;
#pragma unroll
        for (int q = 0; q < 10; ++q) { const int pp = p0_ + F.wave * 8 - 1 + q;
            if (pp >= 0 && pp < L_) { const int rr = lat_ ? lat_row(b_, pp, cm) : (b_ * LC + pp); dst[q] = *(const u32x4*)(P + (size_t)rr * EVN + 1536 + c0); }
            else dst[q] = (u32x4){0u, 0u, 0u, 0u}; } };
    if (F.bid < NU_L + NU_C) load_part0(F.bid, pre);
    for (int unit = F.bid; unit < NU_L + NU_C; unit += F.G) {
        const bool lat = unit < NU_L; const int L = lat ? SEQ : LC; const int uu = lat ? unit : unit - NU_L;
        const int tpb = L / 64, b = uu / tpb, p0 = (uu % tpb) * 64;
        __syncthreads();
        {
            float x1r[8][8];
#pragma unroll
            for (int part = 0; part < 3; ++part) {
                asm volatile("" ::: "memory");
                float kw[3][8], kb[8];
                { const f32x4 ba_ = *(const f32x4*)(cb + part * 512 + c0), bb_ = *(const f32x4*)(cb + part * 512 + c0 + 4);
#pragma unroll
                  for (int j = 0; j < 4; ++j) { kb[j] = ba_[j]; kb[4 + j] = bb_[j]; } }
#pragma unroll
                for (int k = 0; k < 3; ++k) { const f32x4 wa_ = *(const f32x4*)(cw + k * 1536 + part * 512 + c0), wb_ = *(const f32x4*)(cw + k * 1536 + part * 512 + c0 + 4);
#pragma unroll
                    for (int j = 0; j < 4; ++j) { kw[k][j] = wa_[j]; kw[k][4 + j] = wb_[j]; } }
                u32x4 rr_[10];
                if (part == 0) {
#pragma unroll
                    for (int q = 0; q < 10; ++q) { asm volatile("" : "+v"(pre[q])); rr_[q] = pre[q]; }
                } else {
#pragma unroll
                    for (int q = 0; q < 10; ++q) { const int pp = p0 + F.wave * 8 - 1 + q;
                        if (pp >= 0 && pp < L) { const int rr = lat ? lat_row(b, pp, cm) : (b * LC + pp); rr_[q] = *(const u32x4*)(P + (size_t)rr * EVN + 1536 + part * 512 + c0); }
                        else rr_[q] = (u32x4){0u, 0u, 0u, 0u}; }
                }
#pragma unroll
                for (int q = 0; q < 8; ++q) {
                    const int pl = F.wave * 8 + q;
                    float y[8];
#pragma unroll
                    for (int j = 0; j < 8; ++j) y[j] = kb[j];
#pragma unroll
                    for (int k = 0; k < 3; ++k) { const unsigned zw[4] = {rr_[q + k].x, rr_[q + k].y, rr_[q + k].z, rr_[q + k].w};
#pragma unroll
                        for (int j = 0; j < 4; ++j) { y[2 * j] += kw[k][2 * j] * bflo(zw[j]); y[2 * j + 1] += kw[k][2 * j + 1] * bfhi(zw[j]); } }
                    if (part == 0) { u32x4 ox; ox.x = pk2(y[0], y[1]); ox.y = pk2(y[2], y[3]); ox.z = pk2(y[4], y[5]); ox.w = pk2(y[6], y[7]); *(LAS u32x4*)(tx + pl * TP + c0) = ox; }
                    else if (part == 1) {
#pragma unroll
                        for (int j = 0; j < 8; ++j) x1r[q][j] = y[j]; }
                    else { u32x4 ow; ow.x = pk2(y[0] * x1r[q][0], y[1] * x1r[q][1]); ow.y = pk2(y[2] * x1r[q][2], y[3] * x1r[q][3]); ow.z = pk2(y[4] * x1r[q][4], y[5] * x1r[q][5]); ow.w = pk2(y[6] * x1r[q][6], y[7] * x1r[q][7]);
                        *(LAS u32x4*)(tw + pl * TP + c0) = ow; }
                }
            }
        }
        { const int un = unit + F.G; load_part0(un < NU_L + NU_C ? un : unit, pre); }
        __syncthreads();
        {
            const int c = F.tid;
            bf16_t* wdst = WT + hy_row(lat, c, b) + p0;
            bf16_t* xdst = XT + hy_row(lat, c, b) + p0;
#pragma unroll 2
            for (int ch = 0; ch < 8; ++ch) {
                unsigned wv[4], xv[4];
#pragma unroll
                for (int k = 0; k < 4; ++k) {
                    wv[k] = (unsigned)tw[(ch * 8 + 2 * k) * TP + c] | ((unsigned)tw[(ch * 8 + 2 * k + 1) * TP + c] << 16);
                    xv[k] = (unsigned)tx[(ch * 8 + 2 * k) * TP + c] | ((unsigned)tx[(ch * 8 + 2 * k + 1) * TP + c] << 16); }
                *(u32x4*)(wdst + ch * 8) = (u32x4){wv[0], wv[1], wv[2], wv[3]};
                *(u32x4*)(xdst + ch * 8) = (u32x4){xv[0], xv[1], xv[2], xv[3]};
            }
        }
    }
    __syncthreads();
}

typedef float f32x16 __attribute__((ext_vector_type(16)));
__device__ __forceinline__ bf16x8 toep_frag(const LAS unsigned* kr32, int v0) {
    const int q0 = v0 >> 1; const unsigned sh = (unsigned)(v0 & 1) * 16u;
    const unsigned d0 = kr32[q0], d1 = kr32[q0 + 1], d2 = kr32[q0 + 2], d3 = kr32[q0 + 3], d4 = kr32[q0 + 4];
    u32x4 o; o.x = __builtin_amdgcn_alignbit(d1, d0, sh); o.y = __builtin_amdgcn_alignbit(d2, d1, sh); o.z = __builtin_amdgcn_alignbit(d3, d2, sh); o.w = __builtin_amdgcn_alignbit(d4, d3, sh);
    return __builtin_bit_cast(bf16x8, o);
}
__device__ __forceinline__ void phase_hyconv2(const Args& a, Frame& F, int i) {
    unsigned char* ws = F.ws;
    const bf16_t* WT = (const bf16_t*)(ws + WS_WT); bf16_t* XT = (bf16_t*)(ws + WS_X0T);
    LAS unsigned* krl = (LAS unsigned*)F.lds;
    const int r = F.lane & 31, h = F.lane >> 5;
    constexpr int NU_L = HYW, NU_C = HYW / 8;
    for (int unit = F.bid; unit < NU_L + NU_C; unit += F.G) {
        const bool lat = unit < NU_L; const int L = lat ? SEQ : LC;
        const int c = lat ? unit : (unit - NU_L) * 8 + F.wave; const int T = lat ? F.wave * 256 : 0;
        const bf16_t* KRg = (const bf16_t*)(ws + WS_KR) + (size_t)i * (9 * MiB / 4) + (lat ? 0 : (size_t)(4 * MiB / 2));
        __syncthreads();
        if (lat) { const u32x4* src = (const u32x4*)(KRg + (size_t)c * 4096); for (int idx = F.tid; idx < 512; idx += 512) *(LAS u32x4*)(krl + idx * 4) = src[idx]; }
        else { const u32x4* src = (const u32x4*)(KRg + (size_t)((unit - NU_L) * 8) * 512); for (int idx = F.tid; idx < 512; idx += 512) *(LAS u32x4*)(krl + idx * 4) = src[idx]; }
        __syncthreads();
        const LAS unsigned* kr32 = lat ? krl : krl + F.wave * 256;
        const bf16_t* wsrc = WT + hy_row(lat, c, r) + 8 * h;
        f32x16 acc[8];
#pragma unroll
        for (int q = 0; q < 8; ++q)
#pragma unroll
            for (int e = 0; e < 16; ++e) acc[q][e] = 0.f;
        bf16x8 win[16];
        const int vb = (L - 1) - T - r + 8 * h;
#pragma unroll
        for (int q = 1; q < 8; ++q) { win[(2 * q) & 15] = toep_frag(kr32, vb - 32 * q); win[(2 * q - 1) & 15] = toep_frag(kr32, vb - 32 * q + 16); }
        const int nso = L / 256;
        constexpr int RD = 2;
        bf16x8 bring[RD];
#pragma unroll
        for (int q = 0; q < RD; ++q) bring[q] = *(const bf16x8*)(wsrc + 16 * q);
        for (int jo = 0; jo < nso; ++jo) {
#pragma unroll
            for (int jj = 0; jj < 16; ++jj) {
                const int s0 = (jo * 16 + jj) * 16;
                const bf16x8 bcur = bring[jj & (RD - 1)];
                const int snext = (s0 + 16 * RD < L) ? s0 + 16 * RD : s0;
                bring[jj & (RD - 1)] = *(const bf16x8*)(wsrc + snext);
                const int v0 = vb + s0, q0 = v0 >> 1; const unsigned sh = (unsigned)(v0 & 1) * 16u;
                const unsigned d0 = kr32[q0], d1 = kr32[q0 + 1], d2 = kr32[q0 + 2], d3 = kr32[q0 + 3], d4 = kr32[q0 + 4];
                __builtin_amdgcn_sched_barrier(0);
#pragma unroll
                for (int q = 7; q >= 1; --q) acc[q] = __builtin_amdgcn_mfma_f32_32x32x16_bf16(win[(2 * q - jj + 16) & 15], bcur, acc[q], 0, 0, 0);
                __builtin_amdgcn_sched_barrier(0);
                { u32x4 o; o.x = __builtin_amdgcn_alignbit(d1, d0, sh); o.y = __builtin_amdgcn_alignbit(d2, d1, sh); o.z = __builtin_amdgcn_alignbit(d3, d2, sh); o.w = __builtin_amdgcn_alignbit(d4, d3, sh);
                  win[(16 - jj) & 15] = __builtin_bit_cast(bf16x8, o); }
                acc[0] = __builtin_amdgcn_mfma_f32_32x32x16_bf16(win[(16 - jj) & 15], bcur, acc[0], 0, 0, 0);
            }
        }
        const float skip = a.in[F.z + I_HYSKIP][i * HYW + c];
        if (lat) {
            __syncthreads();
            LAS unsigned char* ep = F.lds + F.wave * 16896;
#pragma unroll
            for (int q = 0; q < 8; ++q)
#pragma unroll
                for (int g = 0; g < 4; ++g) { u32x2 yv; yv.x = pk2(acc[q][4 * g + 0], acc[q][4 * g + 1]); yv.y = pk2(acc[q][4 * g + 2], acc[q][4 * g + 3]);
                    *(LAS u32x2*)(ep + r * 528 + (32 * q + 8 * g + 4 * h) * 2) = yv; }
            LDS_WAIT(); asm volatile("" ::: "memory");
#pragma unroll 1
            for (int hb = 0; hb < 4; ++hb) {
                u32x4 wv8[4], xv8[4];
#pragma unroll
                for (int j = 0; j < 4; ++j) { const int ch = (hb * 4 + j) * 64 + F.lane; const int row = ch >> 5, tc = ch & 31; const size_t off = hy_row(true, c, row) + T + tc * 8;
                    wv8[j] = *(const u32x4*)(WT + off); xv8[j] = *(const u32x4*)(XT + off); }
                __builtin_amdgcn_sched_barrier(0);
#pragma unroll
                for (int j = 0; j < 4; ++j) { const int ch = (hb * 4 + j) * 64 + F.lane; const int row = ch >> 5, tc = ch & 31; const size_t off = hy_row(true, c, row) + T + tc * 8;
                    const u32x4 yv = *(const LAS u32x4*)(ep + row * 528 + tc * 16);
                    const unsigned yw[4] = {yv.x, yv.y, yv.z, yv.w}, ww[4] = {wv8[j].x, wv8[j].y, wv8[j].z, wv8[j].w}, xw[4] = {xv8[j].x, xv8[j].y, xv8[j].z, xv8[j].w};
                    unsigned ow[4];
#pragma unroll
                    for (int e = 0; e < 4; ++e) ow[e] = pk2(bflo(xw[e]) * (bflo(yw[e]) + skip * bflo(ww[e])), bfhi(xw[e]) * (bfhi(yw[e]) + skip * bfhi(ww[e])));
                    *(u32x4*)(XT + off) = (u32x4){ow[0], ow[1], ow[2], ow[3]}; }
                __builtin_amdgcn_sched_barrier(0);
            }
        } else {
            const size_t rowoff = hy_row(false, c, r);
#pragma unroll
            for (int q = 0; q < 8; ++q)
#pragma unroll
                for (int g = 0; g < 4; ++g) {
                    const int t = T + 32 * q + 8 * g + 4 * h;
                    const u32x2 wv = *(const u32x2*)(WT + rowoff + t); const u32x2 xv = *(const u32x2*)(XT + rowoff + t);
                    const float o0 = bflo(xv.x) * (acc[q][4 * g + 0] + skip * bflo(wv.x)), o1 = bfhi(xv.x) * (acc[q][4 * g + 1] + skip * bfhi(wv.x));
                    const float o2 = bflo(xv.y) * (acc[q][4 * g + 2] + skip * bflo(wv.y)), o3 = bfhi(xv.y) * (acc[q][4 * g + 3] + skip * bfhi(wv.y));
                    u32x2 ov; ov.x = pk2(o0, o1); ov.y = pk2(o2, o3);
                    *(u32x2*)(XT + rowoff + t) = ov;
                }
        }
    }
    __syncthreads();
}
__device__ __forceinline__ void phase_hyfin(const Args& a, Frame& F, bool cm) {
    unsigned char* ws = F.ws;
    const bf16_t* XT = (const bf16_t*)(ws + WS_X0T); bf16_t* ACT = (bf16_t*)(ws + WS_ACT);
    constexpr int TP = 520;
    LAS bf16_t* tl = (LAS bf16_t*)F.lds;
    constexpr int NU_L = NB * (SEQ / 64), NU_C = NB * (LC / 64);
    u32x4 pv[8];
    auto request = [&](const int un) __attribute__((always_inline)) {
        const bool lat_ = un < NU_L; const int L_ = lat_ ? SEQ : LC; const int uu_ = lat_ ? un : un - NU_L; const int tpb_ = L_ / 64, b_ = uu_ / tpb_, p0_ = (uu_ % tpb_) * 64;
        const bf16_t* src = XT + hy_row(lat_, F.tid, b_) + p0_;
#pragma unroll
        for (int ch = 0; ch < 8; ++ch) pv[ch] = *(const u32x4*)(src + ch * 8); };
    if (F.bid < NU_L + NU_C) request(F.bid);
    for (int unit = F.bid; unit < NU_L + NU_C; unit += F.G) {
        const bool lat = unit < NU_L; const int L = lat ? SEQ : LC; const int uu = lat ? unit : unit - NU_L;
        const int tpb = L / 64, b = uu / tpb, p0 = (uu % tpb) * 64;
        __syncthreads();
        {
            const int c = F.tid;
#pragma unroll
            for (int ch = 0; ch < 8; ++ch) { asm volatile("" : "+v"(pv[ch])); const u32x4 v = pv[ch]; const unsigned vw[4] = {v.x, v.y, v.z, v.w};
#pragma unroll
                for (int k = 0; k < 4; ++k) { tl[(ch * 8 + 2 * k) * TP + c] = (bf16_t)(vw[k] & 0xffffu); tl[(ch * 8 + 2 * k + 1) * TP + c] = (bf16_t)(vw[k] >> 16); } }
        }
        { const int un = unit + F.G; request(un < NU_L + NU_C ? un : unit); }
        __syncthreads();
        for (int q = 0; q < 8; ++q) { const int pl = F.wave * 8 + q, pos = p0 + pl; const int row = lat ? lat_row(b, pos, cm) : (b * LC + pos);
            *(u32x4*)(ACT + (size_t)row * D + 512 + F.lane * 8) = *(const LAS u32x4*)(tl + pl * TP + F.lane * 8); }
    }
    __syncthreads();
}

__device__ __forceinline__ void phase_readout(const Args& a, Frame& F, int i) {
    unsigned char* ws = F.ws;
    const bf16_t* P = (const bf16_t*)(ws + WS_P); const unsigned char* OF = ws + WS_OF; const unsigned char* OB = ws + WS_OB; bf16_t* ACT = (bf16_t*)(ws + WS_ACT);
    const int c0 = F.lane * 8; float gn[8];
#pragma unroll
    for (int j = 0; j < 8; ++j) gn[j] = a.in[F.z + I_GLAN][i * 128 + ((c0 + j) & 127)];
    const int NGW = F.G * 8;
    for (int row0 = F.bid * 8 + F.wave; row0 < RT; row0 += 6 * NGW) {
      u32x2 fa4[6], fb4[6]; u32x4 gg4[6];
#pragma unroll
      for (int jr = 0; jr < 6; ++jr) { const int rw = row0 + jr * NGW; const size_t rq = (size_t)(rw < RT ? rw : row0);
          fa4[jr] = *(const u32x2*)(OF + rq * 512 + c0); fb4[jr] = *(const u32x2*)(OB + rq * 512 + c0); gg4[jr] = *(const u32x4*)(P + rq * EVN + 1024 + c0); }
      __builtin_amdgcn_sched_barrier(0);
#pragma unroll
      for (int jr = 0; jr < 6; ++jr) { const int row = row0 + jr * NGW; if (row >= RT) break;
        const u32x2 fa = fa4[jr], fb = fb4[jr]; const u32x4 gg = gg4[jr];
        const unsigned gw[4] = {gg.x, gg.y, gg.z, gg.w};
        const f32x4 oa = up4_fp8(fa.x) + up4_fp8(fb.x), ob = up4_fp8(fa.y) + up4_fp8(fb.y);
        float o[8], g[8]; float ss = 0.f;
#pragma unroll
        for (int j = 0; j < 4; ++j) { o[j] = oa[j] * (1.0f / SC_O); o[4 + j] = ob[j] * (1.0f / SC_O); g[2 * j] = bflo(gw[j]); g[2 * j + 1] = bfhi(gw[j]); }
#pragma unroll
        for (int j = 0; j < 8; ++j) ss += o[j] * o[j];
        ss += __builtin_bit_cast(float, __builtin_amdgcn_update_dpp(0, __builtin_bit_cast(int, ss), 0x128, 0xf, 0xf, false));
        ss += __builtin_bit_cast(float, __builtin_amdgcn_update_dpp(0, __builtin_bit_cast(int, ss), 0x124, 0xf, 0xf, false));
        ss += __builtin_bit_cast(float, __builtin_amdgcn_update_dpp(0, __builtin_bit_cast(int, ss), 0x122, 0xf, 0xf, false));
        ss += __builtin_bit_cast(float, __builtin_amdgcn_update_dpp(0, __builtin_bit_cast(int, ss), 0x121, 0xf, 0xf, false));
        const float rstd = __builtin_amdgcn_rsqf(ss * (1.0f / 128.0f) + EPS);
        float r[8];
#pragma unroll
        for (int j = 0; j < 8; ++j) { r[j] = o[j] * rstd * gn[j] * silu_f(g[j]); }
        u32x4 w; w.x = pk2(r[0], r[1]); w.y = pk2(r[2], r[3]); w.z = pk2(r[4], r[5]); w.w = pk2(r[6], r[7]);
        *(u32x4*)(ACT + (size_t)row * D + c0) = w;
      }
    }
}

__device__ __forceinline__ void phase_oddmix(const Args& a, Frame& F, int i, bool cm, int rlo) {
    unsigned char* ws = F.ws;
    const bf16_t* P = (const bf16_t*)(ws + WS_P); unsigned char* ACT8 = ws + WS_ACT;
    const float* cw = a.in[F.z + I_ODCW] + (size_t)i * 3 * D;
    const int NGW = F.G * 8; const int nunits = ((RT - rlo) / 8) * 2;
    for (int unit = F.bid * 8 + F.wave; unit < nunits; unit += NGW) {
        const int hh = unit & 1, g = rlo + (unit >> 1) * 8;
        const bool lat = g >= RC; const int L = lat ? SEQ : LC; const int b = lat ? ((g - RC) >> 11) : (g >> 8); const int p0 = lat ? ((g - RC) & 2047) : (g & 255);
        const int c0 = hh * 512 + F.lane * 8;
        float w[3][8];
#pragma unroll
        for (int k = 0; k < 3; ++k) { const f32x4 wa = *(const f32x4*)(cw + k * D + c0), wb = *(const f32x4*)(cw + k * D + c0 + 4);
#pragma unroll
            for (int j = 0; j < 4; ++j) { w[k][j] = wa[j] * SC_Z; w[k][4 + j] = wb[j] * SC_Z; } }
        auto rowof = [&](int p) -> int { return lat ? lat_row(b, p, cm) : (b * LC + p); };
        u32x4 rc[10], rb[8];
#pragma unroll
        for (int q = 0; q < 10; ++q) { const int p = p0 - 1 + q;
            if (p >= 0 && p < L) { const bf16_t* pr = P + (size_t)rowof(p) * ODP; rc[q] = *(const u32x4*)(pr + 1024 + c0); if (q >= 1 && q <= 8) rb[q - 1] = *(const u32x4*)(pr + c0); }
            else rc[q] = (u32x4){0u, 0u, 0u, 0u}; }
        float pv[3][8];
#pragma unroll
        for (int q = 0; q < 10; ++q) {
            const unsigned cwv[4] = {rc[q].x, rc[q].y, rc[q].z, rc[q].w};
#pragma unroll
            for (int j = 0; j < 4; ++j) { pv[q % 3][2 * j] = bflo(cwv[j]); pv[q % 3][2 * j + 1] = bfhi(cwv[j]); }
            if (q >= 2) {
                const int qo = q - 2; const unsigned bw[4] = {rb[qo].x, rb[qo].y, rb[qo].z, rb[qo].w};
                float sacc[8];
#pragma unroll
                for (int j = 0; j < 8; ++j) sacc[j] = w[0][j] * pv[(q - 2) % 3][j] + w[1][j] * pv[(q - 1) % 3][j] + w[2][j] * pv[q % 3][j];
                u32x2 o; o.x = pk4_fp8(bflo(bw[0]) * sacc[0], bfhi(bw[0]) * sacc[1], bflo(bw[1]) * sacc[2], bfhi(bw[1]) * sacc[3]);
                o.y = pk4_fp8(bflo(bw[2]) * sacc[4], bfhi(bw[2]) * sacc[5], bflo(bw[3]) * sacc[6], bfhi(bw[3]) * sacc[7]);
                *(u32x2*)(ACT8 + (size_t)rowof(p0 + qo) * D + c0) = o;
            }
        }
    }
}

#ifndef EN_PRE
#define EN_PRE 1
#endif
#ifndef EN_NORM1
#define EN_NORM1 1
#endif
#ifndef EN_GIN
#define EN_GIN 1
#endif
#ifndef EN_GLA
#define EN_GLA 1
#endif
#ifndef EN_HYPRE
#define EN_HYPRE 1
#endif
#ifndef EN_ODD
#define EN_ODD 1
#endif
#ifndef EN_HYCONV
#define EN_HYCONV 1
#endif
#ifndef EN_READ
#define EN_READ 1
#endif
#ifndef EN_GOUT
#define EN_GOUT 1
#endif
#ifndef EN_EXPC
#define EN_EXPC 1
#endif
#ifndef EN_NORM2
#define EN_NORM2 1
#endif
#ifndef EN_MOE1
#define EN_MOE1 1
#endif
#ifndef EN_MOE2
#define EN_MOE2 1
#endif
constexpr int N_PHASES = 38, PH_FINAL = 37;
__global__ void __launch_bounds__(512, 2) fwd_kernel(Args args) {
    extern __shared__ __attribute__((aligned(16))) unsigned char lds_raw[];
    Frame F;
    F.lds = (LAS unsigned char*)lds_raw;
    F.MISC = (volatile LAS unsigned*)(F.lds + LDS_MISC);
    F.tid = threadIdx.x; F.lane = F.tid & 63; F.wave = __builtin_amdgcn_readfirstlane(F.tid >> 6);
    F.G = gridDim.x; F.bid = blockIdx.x; F.z = 0; F.ws = args.ws;
    unsigned char* ws = args.ws;
    for (int u = F.tid; u < (LDS_BYTES - LDS_MISC) / 4; u += 512) ((LAS unsigned*)(F.lds + LDS_MISC))[u] = 0u;
    __syncthreads();
    XcdBarrier bar; bar.bar = (unsigned*)(ws + WS_CTL) + CW_BAR; bar.x = 0; bar.st = nullptr;
    if (args.fused) bar = xcd_barrier_post((unsigned*)(ws + WS_CTL) + CW_BAR, F.MISC + MW_BAR);
    const int lo = args.ph_lo, hi = args.ph_hi;
#define IN(k) (lo <= (k) && (k) < hi)
#define ENTER() do { int z_; asm volatile("s_mov_b32 %0, 0" : "=s"(z_)); F.z = z_; F.tid = (int)threadIdx.x + z_; F.lane = F.tid & 63; F.wave = __builtin_amdgcn_readfirstlane(F.tid >> 6); F.bid = (int)blockIdx.x + z_; F.ws = args.ws + z_; ws = F.ws; } while (0)
#define SEAM(k) do { if (args.fused && IN((k) + 1)) { xcd_barrier(bar); } } while (0)

    if (IN(0)) { ENTER(); if (EN_PRE) phase_pre(args, F); SEAM(0); }

    for (int l = 0; l < DEPTH; ++l) {
        const int pb = 1 + 9 * l; const int i = l >> 1; const bool even = (l & 1) == 0; const bool cm = (i & 1) == 1;
        const int rlo = (l == 3) ? RC : 0;
        const int nM = (RT - rlo) / 256;
        if (IN(pb + 0)) { ENTER(); if (EN_NORM1) phase_norm1(args, F, l); SEAM(pb + 0); }
        if (IN(pb + 1)) { ENTER();
            ProbIn p; p.A = (const bf16_t*)(ws + WS_ACT); p.O = (bf16_t*)(ws + WS_P); p.K = D; p.nM = nM; p.row0 = rlo; p.G = F.G; p.c = F.bid;
            p.Gd = (bf16_t*)(ws + WS_G); p.gbf = args.in[F.z + I_BAF] + i * 256; p.gbb = args.in[F.z + I_BAB] + i * 256;
            if (even) { p.Bt = (const bf16_t*)(ws + WS_WEVIN) + (size_t)i * EVNP * D; p.nN = EVNP / 256; p.ncols = EVN; p.ldc = EVN; p.prod0 = 1 << 30; }
            else { p.Bt = (const bf16_t*)(ws + WS_WODIN) + (size_t)i * ODN * D; p.nN = ODN / 256; p.ncols = ODN; p.ldc = ODP; p.prod0 = 1024; }
            if (EN_GIN) pg8::gemm_phase<ProbIn>(F.lds, p, F.tid);
            SEAM(pb + 1);
        }
        if (IN(pb + 2)) { ENTER();
            if (even) { if (EN_GLA) phase_gla2(args, F, i, cm); if (EN_HYPRE) phase_hypre2(args, F, i, cm); }
            else if (EN_ODD) phase_oddmix(args, F, i, cm, rlo);
            SEAM(pb + 2);
        }
        if (IN(pb + 3) && even) { ENTER();
            if (EN_HYCONV) phase_hyconv2(args, F, i);
            SEAM(pb + 3);
        }
        if (IN(pb + 4) && even) { ENTER();
            phase_hyfin(args, F, cm);
            if (EN_READ) phase_readout(args, F, i);
            SEAM(pb + 4);
        }
        if (IN(pb + 5)) { ENTER();
            if (even) {
                ProbOut<false> p; p.A = ws + WS_ACT; p.K = D; p.nM = nM; p.nN = 4; p.row0 = rlo; p.G = F.G; p.c = F.bid;
                p.Bt = ws + WS_WEVOUT + (size_t)i * D * D * 2;
                p.x_c = args.in[F.z + I_CTX]; p.x_l = args.in[F.z + I_X]; p.first = (l == 0); p.H16 = (bf16_t*)(ws + WS_H16); p.gate = (const float*)(ws + WS_MOD) + (size_t)l * 33 * 6144 + 2 * D;
                if (EN_GOUT) pg8::gemm_phase<ProbOut<false>>(F.lds, p, F.tid);
            } else {
                ProbOut<true> p; p.A = ws + WS_ACT; p.K = D; p.nM = nM; p.nN = 4; p.row0 = rlo; p.G = F.G; p.c = F.bid;
                p.Bt = ws + WS_WODOUT + (size_t)i * D * D;
                p.x_c = args.in[F.z + I_CTX]; p.x_l = args.in[F.z + I_X]; p.first = 0; p.H16 = (bf16_t*)(ws + WS_H16); p.gate = (const float*)(ws + WS_MOD) + (size_t)l * 33 * 6144 + 2 * D;
                if (EN_GOUT) pg8::gemm_phase<ProbOut<true>>(F.lds, p, F.tid);
            }
            if (EN_EXPC) phase_expconv(args, F, l);
            SEAM(pb + 5);
        }
        if (IN(pb + 6)) { ENTER(); if (EN_NORM2) phase_norm2(args, F, l); SEAM(pb + 6); }
        if (IN(pb + 7)) { ENTER();
            build_tiles(F, (const unsigned*)(ws + WS_CTL) + CW_CNT + l * 32, true);
            ProbMoe1 p; p.A = ws + WS_ACT; p.W13 = ws + WS_EXP; p.H = ws + WS_H; p.toks = (const int*)(ws + WS_TOK);
            p.K = D; p.ntiles = (int)F.MISC[MW_TSTART + NEXP]; p.G = F.G; p.c = F.bid; p.misc = F.MISC;
            if (EN_MOE1) pg8::gemm_phase<ProbMoe1>(F.lds, p, F.tid);
            SEAM(pb + 7);
        }
        if (IN(pb + 8)) { ENTER();
            if (!args.fused) build_tiles(F, (const unsigned*)(ws + WS_CTL) + CW_CNT + l * 32, true);
            ProbMoe2 p; p.Hb = ws + WS_H; p.W2T = ws + WS_W2T; p.Y = ws + WS_Y;
            p.K = DE; p.ntiles = (int)F.MISC[MW_TSTART + NEXP]; p.G = F.G; p.c = F.bid; p.misc = F.MISC;
            if (EN_MOE2) pg8::gemm_phase<ProbMoe2>(F.lds, p, F.tid);
            SEAM(pb + 8);
        }
    }
    if (IN(PH_FINAL)) { ENTER(); if (EN_NORM1) phase_norm1(args, F, DEPTH); }
#undef IN
#undef SEAM
}

#ifndef MK_FUSED
#define MK_FUSED 1
#endif
extern "C" void kernel_launch(void* const* d_in, const int* in_sizes, int n_in, void* d_out, int out_size, void* d_ws, size_t ws_size, hipStream_t stream) {
    static int grid = 0;
    if (grid == 0) {
        if (n_in != N_IN || out_size != RL * D || ws_size < WS_END) { fprintf(stderr, "kernel_launch: unexpected shapes (n_in %d, out %d, ws %zu)\n", n_in, out_size, ws_size); grid = -1; return; }
        int dev = 0, cus = 0, per_cu = 0;
        if (hipGetDevice(&dev) != hipSuccess || hipDeviceGetAttribute(&cus, hipDeviceAttributeMultiprocessorCount, dev) != hipSuccess) { grid = -1; return; }
        if (hipFuncSetAttribute((const void*)fwd_kernel, hipFuncAttributeMaxDynamicSharedMemorySize, LDS_BYTES) != hipSuccess) { fprintf(stderr, "kernel_launch: hipFuncSetAttribute failed\n"); grid = -1; return; }
        if (hipOccupancyMaxActiveBlocksPerMultiprocessor(&per_cu, (const void*)fwd_kernel, 512, LDS_BYTES) != hipSuccess || per_cu < 1) { fprintf(stderr, "kernel_launch: occupancy query says %d\n", per_cu); }
        (void)hipGetLastError();
        grid = cus;
    }
    if (grid < 0) return;
    (void)hipMemsetAsync((char*)d_ws + WS_CTL, 0, CTL_BYTES, stream);
    Args a{};
    for (int i = 0; i < N_IN; ++i) a.in[i] = (const float*)d_in[i];
    a.out = (float*)d_out; a.ws = (unsigned char*)d_ws; a.pad = 0;
#if MK_FUSED
    a.ph_lo = 0; a.ph_hi = N_PHASES; a.fused = 1;
    hipLaunchKernelGGL(fwd_kernel, dim3(grid), dim3(512), LDS_BYTES, stream, a);
#else
    for (int ph = 0; ph < N_PHASES; ++ph) {
        if (ph >= 1 && ph < PH_FINAL) { const int k = (ph - 1) % 9, l = (ph - 1) / 9; if ((k == 3 || k == 4) && (l & 1)) continue; }
        a.ph_lo = ph; a.ph_hi = ph + 1; a.fused = 0;
        hipLaunchKernelGGL(fwd_kernel, dim3(grid), dim3(512), LDS_BYTES, stream, a);
    }
#endif
}
```
